# Optimizing an MI355X kernel written in HIP

```python
import jax, jax.numpy as jnp
from jax import lax
import numpy as np

D_MODEL = 1024
BATCH = 16
SEQ = 256
DEPTH = 1
DEC_BATCH = 4
DEC_SEQ = 4096
PAST_LEN = 256

GRID_W = 64
N_FOURIER_GROUPS = 4
FOURIER_GROUP_W = 128
D_FOURIER = N_FOURIER_GROUPS * FOURIER_GROUP_W
N_HEADS = 4
DK_HEAD = 128
DV_HEAD = 256
DK_TOT = N_HEADS * DK_HEAD
DV_TOT = N_HEADS * DV_HEAD
GATE_RANK = 16
GATE_TEMP = 16.0
CHUNK = 32
D_FF = 2816
N_MOD = 9
RMS_EPS = 1e-6
POS_BASE = 10000.0
IN_COLS = D_FOURIER + 2 * DK_TOT + 2 * DV_TOT + 2 * GATE_RANK + 2 * D_MODEL

kernel_name = "hybrid_fnet_gla_macaron_dit_step"


def rms_norm(x, gain):
    x32 = x.astype(jnp.float32)
    y = x32 * lax.rsqrt(jnp.mean(x32 * x32, axis=-1, keepdims=True) + RMS_EPS)
    return (y * gain.astype(jnp.float32)).astype(x.dtype)


def modulate(h, shift, scale):
    return h * (1.0 + scale) + shift


def swiglu(h, w_gate, w_up, w_down):
    return (jax.nn.silu(h @ w_gate) * (h @ w_up)) @ w_down


def grid_pos_embed(n_tokens, dtype):
    rows = n_tokens // GRID_W
    row = jnp.repeat(jnp.arange(rows, dtype=jnp.float32), GRID_W)
    col = jnp.tile(jnp.arange(GRID_W, dtype=jnp.float32), rows)
    n_freq = D_MODEL // 4
    omega = POS_BASE ** (-jnp.arange(n_freq, dtype=jnp.float32) / n_freq)
    ra = row[:, None] * omega
    ca = col[:, None] * omega
    return jnp.concatenate([jnp.sin(ra), jnp.cos(ra), jnp.sin(ca), jnp.cos(ca)], axis=-1).astype(dtype)


def fourier_mix(f):
    B, T, _ = f.shape
    g = f.astype(jnp.float32).reshape(B, T, N_FOURIER_GROUPS, FOURIER_GROUP_W).transpose(0, 2, 1, 3)
    m = jnp.fft.fft2(g, norm="ortho").real
    return m.transpose(0, 2, 1, 3).reshape(B, T, D_FOURIER)


def _to_chunks(x):
    B, T, H, d = x.shape
    return x.reshape(B, T // CHUNK, CHUNK, H, d).transpose(1, 0, 3, 2, 4)


def gla_chunked(q, k, v, log_a, s0):
    B, T = q.shape[0], q.shape[1]
    mask = jnp.tril(jnp.ones((CHUNK, CHUNK), dtype=bool))[:, :, None]

    def step(S, inp):
        qc, kc, vc, ac = inp
        b = jnp.cumsum(ac, axis=2)
        o_inter = jnp.einsum('bhid,bhdv->bhiv', qc * jnp.exp(b), S)
        diff = b[:, :, :, None, :] - b[:, :, None, :, :]
        decay = jnp.where(mask, jnp.exp(jnp.minimum(diff, 0.0)), 0.0)
        scores = jnp.einsum('bhid,bhjd,bhijd->bhij', qc, kc, decay)
        o_intra = jnp.einsum('bhij,bhjv->bhiv', scores, vc)
        b_last = b[:, :, -1, :]
        S_new = jnp.exp(b_last)[..., None] * S + jnp.einsum(
            'bhjd,bhjv->bhdv', kc * jnp.exp(b_last[:, :, None, :] - b), vc)
        return S_new, o_inter + o_intra

    s_final, o = lax.scan(step, s0.astype(jnp.float32),
                          (_to_chunks(q), _to_chunks(k), _to_chunks(v), _to_chunks(log_a)))
    o = o.transpose(1, 0, 3, 2, 4).reshape(B, T, N_HEADS, DV_HEAD)
    return o, s_final


def mixer(h, s_fwd, s_bwd, w_in, w_alpha_fwd, b_alpha_fwd, w_alpha_bwd, b_alpha_bwd,
          gla_norm, w_proj_fourier, w_proj_gla, w_out):
    B, T, _ = h.shape
    z = h @ w_in
    cuts = [D_FOURIER, D_FOURIER + DK_TOT, D_FOURIER + 2 * DK_TOT, D_FOURIER + 2 * DK_TOT + DV_TOT,
            D_FOURIER + 2 * DK_TOT + 2 * DV_TOT, D_FOURIER + 2 * DK_TOT + 2 * DV_TOT + 2 * GATE_RANK]
    f, q, k, v, r, a_lr, g = jnp.split(z, cuts, axis=-1)

    branch_a = fourier_mix(f).astype(h.dtype) @ w_proj_fourier

    qh = q.astype(jnp.float32).reshape(B, T, N_HEADS, DK_HEAD) * (DK_HEAD ** -0.5)
    kh = k.astype(jnp.float32).reshape(B, T, N_HEADS, DK_HEAD)
    vh = v.astype(jnp.float32).reshape(B, T, N_HEADS, DV_HEAD)
    a32 = a_lr.astype(jnp.float32)
    la_f = jax.nn.log_sigmoid(a32[..., :GATE_RANK] @ w_alpha_fwd.astype(jnp.float32)
                              + b_alpha_fwd.astype(jnp.float32)) / GATE_TEMP
    la_b = jax.nn.log_sigmoid(a32[..., GATE_RANK:] @ w_alpha_bwd.astype(jnp.float32)
                              + b_alpha_bwd.astype(jnp.float32)) / GATE_TEMP
    la_f = la_f.reshape(B, T, N_HEADS, DK_HEAD)
    la_b = la_b.reshape(B, T, N_HEADS, DK_HEAD)
    o_f, sf = gla_chunked(qh, kh, vh, la_f, s_fwd)
    o_b, sb = gla_chunked(jnp.flip(qh, 1), jnp.flip(kh, 1), jnp.flip(vh, 1), jnp.flip(la_b, 1), s_bwd)
    o = o_f + jnp.flip(o_b, 1)
    o = o * lax.rsqrt(jnp.mean(o * o, axis=-1, keepdims=True) + RMS_EPS)
    o = o.reshape(B, T, DV_TOT) * gla_norm.astype(jnp.float32)
    o = (o * jax.nn.silu(r.astype(jnp.float32))).astype(h.dtype)
    branch_b = o @ w_proj_gla

    g_a, g_b = jnp.split(jax.nn.sigmoid(g), 2, axis=-1)
    y = (g_a * branch_a + g_b * branch_b) @ w_out
    return y, sf, sb


def trunk_layer(x, mod, s_fwd, s_bwd, norm_ffn1, w_ffn1_gate, w_ffn1_up, w_ffn1_down,
                norm_mix, w_in, w_alpha_fwd, b_alpha_fwd, w_alpha_bwd, b_alpha_bwd, gla_norm,
                w_proj_fourier, w_proj_gla, w_out, norm_ffn2, w_ffn2_gate, w_ffn2_up, w_ffn2_down):
    sh1, sc1, gt1, sh2, sc2, gt2, sh3, sc3, gt3 = jnp.split(mod, N_MOD, axis=-1)
    h = modulate(rms_norm(x, norm_ffn1), sh1, sc1)
    x = x + (0.5 * gt1 * swiglu(h, w_ffn1_gate, w_ffn1_up, w_ffn1_down)).astype(x.dtype)
    h = modulate(rms_norm(x, norm_mix), sh2, sc2).astype(x.dtype)
    y, sf, sb = mixer(h, s_fwd, s_bwd, w_in, w_alpha_fwd, b_alpha_fwd, w_alpha_bwd, b_alpha_bwd,
                      gla_norm, w_proj_fourier, w_proj_gla, w_out)
    x = x + (gt2 * y).astype(x.dtype)
    h = modulate(rms_norm(x, norm_ffn2), sh3, sc3)
    x = x + (0.5 * gt3 * swiglu(h, w_ffn2_gate, w_ffn2_up, w_ffn2_down)).astype(x.dtype)
    return x, sf, sb


def setup_inputs(seed: int = 0) -> dict:
    key = jax.random.key(seed)
    ks = jax.random.split(key, 32)
    L, D = DEPTH, D_MODEL

    def nrm(k, shape, scale):
        return jax.random.normal(k, shape, jnp.float32) * scale

    def gain(k, shape):
        return 1.0 + 0.02 * jax.random.normal(k, shape, jnp.float32)

    st_shape = (DEC_BATCH, L, N_HEADS, DK_HEAD, DV_HEAD)
    return {
        "x_prompt": nrm(ks[0], (BATCH, SEQ, D), 1.0),
        "x_sample": nrm(ks[1], (DEC_BATCH, DEC_SEQ, D), 1.0),
        "state_gla_fwd": nrm(ks[2], st_shape, 1.0),
        "state_gla_bwd": nrm(ks[3], st_shape, 1.0),
        "c": nrm(ks[4], (DEC_BATCH, D), 1.0),
        "c_ctx": nrm(ks[5], (D,), 1.0),
        "w_ada": nrm(ks[6], (L, D, N_MOD * D), D ** -0.5),
        "b_ada": nrm(ks[7], (L, N_MOD * D), 0.02),
        "norm_ffn1": gain(ks[8], (L, D)),
        "w_ffn1_gate": nrm(ks[9], (L, D, D_FF), D ** -0.5),
        "w_ffn1_up": nrm(ks[10], (L, D, D_FF), D ** -0.5),
        "w_ffn1_down": nrm(ks[11], (L, D_FF, D), D_FF ** -0.5),
        "norm_mix": gain(ks[12], (L, D)),
        "w_in": nrm(ks[13], (L, D, IN_COLS), D ** -0.5),
        "w_alpha_fwd": nrm(ks[14], (L, GATE_RANK, DK_TOT), GATE_RANK ** -0.5),
        "b_alpha_fwd": nrm(ks[15], (L, DK_TOT), 0.1),
        "w_alpha_bwd": nrm(ks[16], (L, GATE_RANK, DK_TOT), GATE_RANK ** -0.5),
        "b_alpha_bwd": nrm(ks[17], (L, DK_TOT), 0.1),
        "gla_norm": gain(ks[18], (L, DV_TOT)),
        "w_proj_fourier": nrm(ks[19], (L, D_FOURIER, D), D_FOURIER ** -0.5),
        "w_proj_gla": nrm(ks[20], (L, DV_TOT, D), DV_TOT ** -0.5),
        "w_out": nrm(ks[21], (L, D, D), D ** -0.5),
        "norm_ffn2": gain(ks[22], (L, D)),
        "w_ffn2_gate": nrm(ks[23], (L, D, D_FF), D ** -0.5),
        "w_ffn2_up": nrm(ks[24], (L, D, D_FF), D ** -0.5),
        "w_ffn2_down": nrm(ks[25], (L, D_FF, D), D_FF ** -0.5),
        "final_norm": gain(ks[26], (D,)),
    }


def reference(x_prompt, x_sample, state_gla_fwd, state_gla_bwd, c, c_ctx, w_ada, b_ada,
              norm_ffn1, w_ffn1_gate, w_ffn1_up, w_ffn1_down, norm_mix, w_in,
              w_alpha_fwd, b_alpha_fwd, w_alpha_bwd, b_alpha_bwd, gla_norm,
              w_proj_fourier, w_proj_gla, w_out, norm_ffn2, w_ffn2_gate, w_ffn2_up, w_ffn2_down,
              final_norm):
    xc = x_prompt
    xl = x_sample + grid_pos_embed(x_sample.shape[1], x_sample.dtype)
    zero_state = jnp.zeros((x_prompt.shape[0], N_HEADS, DK_HEAD, DV_HEAD), jnp.float32)
    new_fwd, new_bwd = [], []
    for l in range(DEPTH):
        prm = (norm_ffn1[l], w_ffn1_gate[l], w_ffn1_up[l], w_ffn1_down[l], norm_mix[l], w_in[l],
               w_alpha_fwd[l], b_alpha_fwd[l], w_alpha_bwd[l], b_alpha_bwd[l], gla_norm[l],
               w_proj_fourier[l], w_proj_gla[l], w_out[l], norm_ffn2[l], w_ffn2_gate[l],
               w_ffn2_up[l], w_ffn2_down[l])
        mod_ctx = (jax.nn.silu(c_ctx) @ w_ada[l] + b_ada[l])[None, None, :]
        mod_lat = (jax.nn.silu(c) @ w_ada[l] + b_ada[l])[:, None, :]
        xc, sf, sb = trunk_layer(xc, mod_ctx, zero_state, zero_state, *prm)
        new_fwd.append(sf)
        new_bwd.append(sb)
        xl, _, _ = trunk_layer(xl, mod_lat, state_gla_fwd[:, l], state_gla_bwd[:, l], *prm)
    y_prompt = rms_norm(xc, final_norm)
    y_sample = rms_norm(xl, final_norm)
    new_state_fwd = jnp.stack(new_fwd, axis=1)
    new_state_bwd = jnp.stack(new_bwd, axis=1)
    return (y_prompt, y_sample, new_state_fwd, new_state_bwd)
```

```cpp
#include <hip/hip_runtime.h>
#include <hip/hip_cooperative_groups.h>
#include <cstdio>
namespace cg = cooperative_groups;

#ifndef MULTI_LAUNCH
#define MULTI_LAUNCH 0
#endif

#ifdef ONLY
#define PH_ON(n) ((n)==ONLY)
#else
#define PH_ON(n) 1
#endif
#define DI __device__ __forceinline__
#define LAS __attribute__((address_space(3)))
typedef unsigned short bf16_t;
typedef short bf16x8 __attribute__((ext_vector_type(8)));
typedef short s16x4 __attribute__((ext_vector_type(4)));
typedef float f32x2 __attribute__((ext_vector_type(2)));
typedef float f32x4 __attribute__((ext_vector_type(4)));
typedef float f32x16 __attribute__((ext_vector_type(16)));
typedef unsigned u32x2 __attribute__((ext_vector_type(2)));
typedef unsigned u32x4 __attribute__((ext_vector_type(4)));
typedef __bf16 bf2_t __attribute__((ext_vector_type(2)));

constexpr int MT = 20480, MCTX = 4096, DM = 1024, DFF = 2816;
constexpr size_t MiB = 1048576;
constexpr size_t OFF_WUP = 0, OFF_WDN = 11 * MiB, OFF_WINS = 16 * MiB + MiB / 2, OFF_WINN = 22 * MiB + MiB / 2, OFF_WPF = 29 * MiB, OFF_WPG = 30 * MiB,
                 OFF_WOUT = 32 * MiB, OFF_SMALL = 34 * MiB, POOL = 36 * MiB;
constexpr size_t OFF_MOD = OFF_SMALL, OFF_DBUF = OFF_SMALL + 256 * 1024, OFF_C256 = POOL + 144 * MiB, OFF_S256 = POOL + 146 * MiB;
constexpr size_t P_A = POOL, P_QKV = POOL + 40 * MiB, P_R = POOL + 120 * MiB, P_ALR = POOL + 160 * MiB, P_U = POOL + 163 * MiB, P_FM = POOL + 200 * MiB,
                 P_DFTC = POOL + 40 * MiB, P_DFTS = POOL + 72 * MiB, P_GT = POOL + 104 * MiB, P_ACT = POOL + 40 * MiB, P_ZG = POOL + 40 * MiB, P_PART = POOL + 40 * MiB;
constexpr size_t WS_NEED = 256 * MiB;
constexpr int LDS_BYTES = 131072 + 16;
constexpr size_t OFF_BAR = OFF_SMALL + MiB;
constexpr int NPHASE = 21;

struct Params { const float* in[27]; float* out; unsigned char* ws; int nseq; int seq[47]; };
typedef const __attribute__((address_space(4))) Params CParams;

DI unsigned opq(unsigned o) { asm volatile("" : "+v"(o)); return o; }
DI int TID() { return (int)opq(__builtin_amdgcn_workitem_id_x()); }
DI int BID() { unsigned b = __builtin_amdgcn_workgroup_id_x(); asm volatile("" : "+s"(b)); return (int)b; }
DI unsigned pk2(float a, float b) { f32x2 v = {a, b}; bf2_t r = __builtin_convertvector(v, bf2_t); return __builtin_bit_cast(unsigned, r); }
DI float bflo(unsigned u) { return __uint_as_float(u << 16); }
DI float bfhi(unsigned u) { return __uint_as_float(u & 0xffff0000u); }
DI float bf2f(bf16_t x) { return __uint_as_float(((unsigned)x) << 16); }
DI float siluf_(float x) { return x * __builtin_amdgcn_rcpf(1.f + __expf(-x)); }
DI int modv(int m) { return m < MCTX ? 4 : ((m - MCTX) >> 12); }

DI void tr_tile(LAS float* tl, const float* src, int ld, int k0, int c0, bf16_t* dst, int ldd, int r0, float scale) {
    const int tid = TID();
    { const int i = tid >> 4, j4 = tid & 15;
#pragma unroll
      for (int h = 0; h < 2; ++h) { const f32x4 v = *(const f32x4*)(src + (size_t)(k0 + i + 32 * h) * ld + c0 + 4 * j4); LAS float* d = tl + (i + 32 * h) * 65 + 4 * j4; d[0] = v[0]; d[1] = v[1]; d[2] = v[2]; d[3] = v[3]; } }
    __syncthreads();
    { const int n = tid >> 3, kk = tid & 7; LAS const float* s = tl + (8 * kk) * 65 + n;
      u32x4 o; o[0] = pk2(s[0] * scale, s[65] * scale); o[1] = pk2(s[130] * scale, s[195] * scale); o[2] = pk2(s[260] * scale, s[325] * scale); o[3] = pk2(s[390] * scale, s[455] * scale);
      *(u32x4*)(dst + (size_t)(r0 + n) * ldd + k0 + 8 * kk) = o; }
    __syncthreads();
}
DI void conv_ffn(LAS float* tl, CParams& p, int which, int first, int stride) {
    const float* wg = p.in[which ? 23 : 9]; const float* wu = p.in[which ? 24 : 10]; const float* wd = p.in[which ? 25 : 11];
    bf16_t* wup = (bf16_t*)(p.ws + OFF_WUP); bf16_t* wdn = (bf16_t*)(p.ws + OFF_WDN);
    for (int j = first; j < 1408 + 704; j += stride) {
        if (j < 1408) { const int q = j >> 4, kt = j & 15; const int pp = q >> 2, bj = (q >> 1) & 1, hf = q & 1;
            tr_tile(tl, bj ? wu : wg, DFF, 64 * kt, 128 * pp + 64 * hf, wup, 1024, 64 * q, 1.f); }
        else { const int jj = j - 1408; const int nb = jj / 44, kt = jj % 44; tr_tile(tl, wd, 1024, 64 * kt, 64 * nb, wdn, DFF, 64 * nb, 1.f); }
    }
}
DI void prep_phase(LAS unsigned char* lds, CParams& p) {
    LAS float* tl = (LAS float*)lds;
    const int tid = TID();
    { const float* c = p.in[4]; const float* cctx = p.in[5]; const float* wada = p.in[6]; float* part = (float*)(p.ws + P_PART);
      for (int job = BID(); job < 256; job += gridDim.x) {
          const int ks = job >> 3, cc = job & 7;
          __syncthreads();
          if (tid < 160) { const int v = tid >> 5, kk = tid & 31; const int k = ks * 32 + kk; const float x = (v < 4) ? c[v * 1024 + k] : cctx[k]; tl[tid] = siluf_(x); }
          __syncthreads();
          if (tid < 288) { const int col = cc * 1152 + 4 * tid; f32x4 a0 = {0, 0, 0, 0}, a1 = a0, a2 = a0, a3 = a0, a4 = a0;
#pragma unroll 8
              for (int kk = 0; kk < 32; ++kk) { const f32x4 w = *(const f32x4*)(wada + (size_t)(ks * 32 + kk) * 9216 + col);
                  a0 += tl[kk] * w; a1 += tl[32 + kk] * w; a2 += tl[64 + kk] * w; a3 += tl[96 + kk] * w; a4 += tl[128 + kk] * w; }
              float* o = part + (size_t)(ks * 5) * 9216 + col; *(f32x4*)o = a0; *(f32x4*)(o + 9216) = a1; *(f32x4*)(o + 2 * 9216) = a2; *(f32x4*)(o + 3 * 9216) = a3; *(f32x4*)(o + 4 * 9216) = a4; }
      }
      __syncthreads(); }
    conv_ffn(tl, p, 0, BID(), gridDim.x);
    { const float* win = p.in[13]; bf16_t* wins = (bf16_t*)(p.ws + OFF_WINS); bf16_t* winn = (bf16_t*)(p.ws + OFF_WINN);
      bf16_t* wpf = (bf16_t*)(p.ws + OFF_WPF); bf16_t* wpg = (bf16_t*)(p.ws + OFF_WPG); bf16_t* wout = (bf16_t*)(p.ws + OFF_WOUT);
      for (int j = BID(); j < 512 + 784 + 128 + 256 + 256; j += gridDim.x) {
          if (j < 512) { const int rb = j >> 4, kt = j & 15; tr_tile(tl, win, 5664, 64 * kt, 512 + 64 * rb, wins, 1024, 1024 + 64 * rb, rb < 8 ? 0.08838834764831845f : 1.f); }
          else if (j < 1296) { const int jj = j - 512; const int rb = jj >> 4, kt = jj & 15; const int c0 = rb < 16 ? 2560 + 64 * rb : (rb < 48 ? 3616 + 64 * (rb - 16) : 3584);
              tr_tile(tl, win, 5664, 64 * kt, c0, winn, 1024, 64 * rb, 1.f); }
          else if (j < 1424) { const int jj = j - 1296; const int rb = jj >> 3, kt = jj & 7; tr_tile(tl, p.in[19], 1024, 64 * kt, 64 * rb, wpf, 1536, 64 * rb, 1.f); }
          else if (j < 1680) { const int jj = j - 1424; const int rb = jj >> 4, kt = jj & 15; tr_tile(tl, p.in[20], 1024, 64 * kt, 64 * rb, wpf + 512, 1536, 64 * rb, 1.f); }
          else { const int jj = j - 1680; const int rb = jj >> 4, kt = jj & 15; tr_tile(tl, p.in[21], 1024, 64 * kt, 64 * rb, wout, 1024, 64 * rb, 1.f); }
      }
      LAS float* wf = tl; LAS float* ct = tl + 64 * 129; LAS float* st = ct + 128;
      for (int j = BID(); j < 128; j += gridDim.x) {
          const int kt = j >> 3, g = (j >> 1) & 3, lh = j & 1;
          __syncthreads();
          if (tid < 128) { float s, c; sincospif((float)tid * (1.f / 64.f), &s, &c); ct[tid] = c; st[tid] = s; }
#pragma unroll
          for (int i = 0; i < 4; ++i) { const int e = tid + 512 * i; const int r = e >> 5, c4 = e & 31; const f32x4 v = *(const f32x4*)(win + (size_t)(64 * kt + r) * 5664 + g * 128 + 4 * c4);
              LAS float* d = wf + r * 129 + 4 * c4; d[0] = v[0]; d[1] = v[1]; d[2] = v[2]; d[3] = v[3]; }
          __syncthreads();
          const int w = tid >> 6, k = tid & 63; const int l0 = 64 * lh + 8 * w;
          float ac[8], as[8];
#pragma unroll
          for (int i = 0; i < 8; ++i) { ac[i] = 0.f; as[i] = 0.f; }
          for (int c = 0; c < 128; ++c) { const float x = wf[k * 129 + c];
#pragma unroll
              for (int i = 0; i < 8; ++i) { const int idx = (c * (l0 + i)) & 127; ac[i] += x * ct[idx]; as[i] += x * st[idx]; } }
#pragma unroll
          for (int i = 0; i < 8; ++i) { const int row = g * 128 + l0 + i; const unsigned a = pk2(ac[i], -as[i]);
              wins[(size_t)row * 1024 + 64 * kt + k] = (bf16_t)(a & 0xffffu); wins[(size_t)(512 + row) * 1024 + 64 * kt + k] = (bf16_t)(a >> 16); }
      }
    }
}
DI void modreduce_phase(CParams& p) {
    const float* part = (const float*)(p.ws + P_PART); const float* bada = p.in[7]; float* mod = (float*)(p.ws + OFF_MOD);
    for (int i = BID() * 512 + TID(); i < 5 * 9216; i += gridDim.x * 512) { const int v = i / 9216, col = i - v * 9216; float s = bada[col];
        for (int ks = 0; ks < 32; ++ks) s += part[(size_t)(ks * 5 + v) * 9216 + col];
        mod[i] = s; }
}
template <int MODE, int NR> DI void norm_rows(CParams& p, int m0, int stride, const f32x4 (&x)[NR][4], const f32x4 (&gain)[4], bf16_t* hbuf) {
    const int lane = TID() & 63;
    float ss[NR];
#pragma unroll
    for (int r = 0; r < NR; ++r) { ss[r] = 0.f;
#pragma unroll
        for (int i = 0; i < 4; ++i) ss[r] += x[r][i][0] * x[r][i][0] + x[r][i][1] * x[r][i][1] + x[r][i][2] * x[r][i][2] + x[r][i][3] * x[r][i][3]; }
#pragma unroll
    for (int o = 32; o >= 1; o >>= 1)
#pragma unroll
        for (int r = 0; r < NR; ++r) ss[r] += __shfl_xor(ss[r], o);
    if (MODE == 3) {
#pragma unroll
        for (int r = 0; r < NR; ++r) { const int m = m0 + r * stride; const float rinv = rsqrtf(ss[r] * (1.f / 1024.f) + 1e-6f); float* xo = p.out + (size_t)m * 1024;
#pragma unroll
            for (int i = 0; i < 4; ++i) *(f32x4*)(xo + 256 * i + 4 * lane) = x[r][i] * rinv * gain[i]; }
    } else {
        u32x2 hv[NR][4];
#pragma unroll
        for (int r = 0; r < NR; ++r) { const int m = m0 + r * stride; const float rinv = rsqrtf(ss[r] * (1.f / 1024.f) + 1e-6f);
            const float* md = (const float*)(p.ws + OFF_MOD) + modv(m) * 9216 + MODE * 3072;
#pragma unroll
            for (int i = 0; i < 4; ++i) { const int c = 256 * i + 4 * lane; const f32x4 sh = *(const f32x4*)(md + c), sc = *(const f32x4*)(md + 1024 + c);
                const f32x4 y = x[r][i] * rinv * gain[i] * (1.f + sc) + sh; hv[r][i][0] = pk2(y[0], y[1]); hv[r][i][1] = pk2(y[2], y[3]); } }
#pragma unroll
        for (int r = 0; r < NR; ++r) { const int m = m0 + r * stride;
#pragma unroll
            for (int i = 0; i < 4; ++i) { const int c = 256 * i + 4 * lane;
                if (MODE == 0) *(f32x4*)(p.out + (size_t)m * 1024 + c) = x[r][i];
                *(u32x2*)(hbuf + (size_t)m * 1024 + c) = hv[r][i]; } }
    }
}
template <int MODE> DI void norm_phase(CParams& p) {
    const int lane = TID() & 63; const int wg = BID() * 8 + (TID() >> 6), nw = gridDim.x * 8;
    const float* gsrc = p.in[MODE == 0 ? 8 : (MODE == 1 ? 12 : (MODE == 2 ? 22 : 26))];
    f32x4 gain[4];
#pragma unroll
    for (int i = 0; i < 4; ++i) gain[i] = *(const f32x4*)(gsrc + 256 * i + 4 * lane);
    bf16_t* hbuf = (bf16_t*)(p.ws + P_A);
    if (MODE == 0) {
        for (int j = wg; j < 2048 + 4096; j += nw) {
            if (j < 2048) { f32x4 x[2][4];
#pragma unroll
                for (int r = 0; r < 2; ++r)
#pragma unroll
                    for (int i = 0; i < 4; ++i) x[r][i] = *(const f32x4*)(p.in[0] + (size_t)(2 * j + r) * 1024 + 256 * i + 4 * lane);
                norm_rows<0, 2>(p, 2 * j, 1, x, gain, hbuf);
            } else {
                const int s = j - 2048; const float row = (float)(s >> 6), col = (float)(s & 63);
                f32x4 x[4][4];
#pragma unroll
                for (int b = 0; b < 4; ++b)
#pragma unroll
                    for (int i = 0; i < 4; ++i) x[b][i] = *(const f32x4*)(p.in[1] + ((size_t)b * 4096 + s) * 1024 + 256 * i + 4 * lane);
                f32x4 pe[4];
#pragma unroll
                for (int e = 0; e < 4; ++e) { const float om = expf(-(float)(4 * lane + e) * (9.210340371976184f / 256.f)); float sr, cr, sc, cc; sincosf(row * om, &sr, &cr); sincosf(col * om, &sc, &cc);
                    pe[0][e] = sr; pe[1][e] = cr; pe[2][e] = sc; pe[3][e] = cc; }
#pragma unroll
                for (int b = 0; b < 4; ++b)
#pragma unroll
                    for (int i = 0; i < 4; ++i) x[b][i] += pe[i];
                norm_rows<0, 4>(p, 4096 + s, 4096, x, gain, hbuf);
            }
        }
    } else {
        for (int j = wg; j < MT / 5; j += nw) { f32x4 x[5][4];
#pragma unroll
            for (int r = 0; r < 5; ++r)
#pragma unroll
                for (int i = 0; i < 4; ++i) x[r][i] = *(const f32x4*)(p.out + (size_t)(5 * j + r) * 1024 + 256 * i + 4 * lane);
            norm_rows<MODE, 5>(p, 5 * j, 1, x, gain, hbuf); }
    }
}
DI void dftgen_phase(LAS unsigned char* lds, CParams& p) {
    LAS float* tab = (LAS float*)lds; const int tid = TID();
    __syncthreads();
    for (int i = tid; i < 4096; i += 512) tab[i] = cospif((float)i * (1.f / 2048.f));
    __syncthreads();
    bf16_t* C = (bf16_t*)(p.ws + P_DFTC); bf16_t* S = (bf16_t*)(p.ws + P_DFTS);
    for (int i = BID() * 512 + tid; i < 4096 * 512; i += gridDim.x * 512) { const int k = i >> 9, t0 = (i & 511) * 8; float c[8], s[8];
#pragma unroll
        for (int e = 0; e < 8; ++e) { const int m = (k * (t0 + e)) & 4095; c[e] = tab[m]; s[e] = tab[(m - 1024) & 4095]; }
        u32x4 oc, os;
#pragma unroll
        for (int e = 0; e < 4; ++e) { oc[e] = pk2(c[2 * e], c[2 * e + 1]); os[e] = pk2(s[2 * e], s[2 * e + 1]); }
        *(u32x4*)(C + (size_t)k * 4096 + t0) = oc; *(u32x4*)(S + (size_t)k * 4096 + t0) = os; }
    bf16_t* C2 = (bf16_t*)(p.ws + OFF_C256); bf16_t* S2 = (bf16_t*)(p.ws + OFF_S256);
    for (int i = BID() * 512 + tid; i < 256 * 32; i += gridDim.x * 512) { const int k = i >> 5, t0 = (i & 31) * 8; float c[8], s[8];
#pragma unroll
        for (int e = 0; e < 8; ++e) { const int m = ((k * (t0 + e)) & 255) * 16; c[e] = tab[m]; s[e] = tab[(m - 1024) & 4095]; }
        u32x4 oc, os;
#pragma unroll
        for (int e = 0; e < 4; ++e) { oc[e] = pk2(c[2 * e], c[2 * e + 1]); os[e] = pk2(s[2 * e], s[2 * e + 1]); }
        *(u32x4*)(C2 + (size_t)k * 4096 + t0) = oc; *(u32x4*)(S2 + (size_t)k * 4096 + t0) = os; }
}
constexpr int HTB = 128 * 64 * 2;
DI int lds_byte(int r, int c) { const int st = (r >> 4) * 2 + (c >> 5), rr = r & 15, cc = c & 31, ob = rr * 64 + cc * 2; return st * 1024 + (ob ^ (((ob >> 9) & 1) << 5)); }
DI void stage_rc(int b, int& R, int& C) { const int st = b / 1024, sb = b % 1024, swz = sb ^ (((sb >> 9) & 1) << 5); R = (st >> 1) * 16 + swz / 64; C = (st & 1) * 32 + (swz % 64) / 2; }
DI int perm32(int rho) { const int n = rho >> 4, i = rho & 15; return 8 * (i >> 2) + 4 * n + (i & 3); }
DI void tile_map(int L, int nM, int nN, int& pm, int& pn) {
    const int nwg = nM * nN; int wgid = L; { const int q = nwg / 8, r = nwg % 8, xcd = wgid % 8, off = wgid / 8; wgid = (xcd < r ? xcd * (q + 1) : r * (q + 1) + (xcd - r) * q) + off; }
    const int nig = 8 * nN, gid = wgid / nig, fm = gid * 8, gsz = (nM - fm) < 8 ? (nM - fm) : 8;
    pm = fm + ((wgid % nig) % gsz); pn = (wgid % nig) / gsz;
}
struct UD { const char* A[2]; const char* B[2]; int lda[2], ldb[2], nt[2]; int nseg, pm, pn, ty; };
enum { K_UP = 0, K_RES = 1, K_SW = 2, K_IN2 = 3, K_PL = 4, K_DFT = 5, K_PROJ = 6, K_RESD = 7 };
template <int KIND> struct KLd { static constexpr int A = 1024, B = 1024; };
template <> struct KLd<K_RESD> { static constexpr int A = DFF, B = DFF; };
template <> struct KLd<K_DFT> { static constexpr int A = 4096, B = MT; };
template <> struct KLd<K_PROJ> { static constexpr int A = 0, B = 1536; };
struct GP { const bf16_t* A; const bf16_t* B; int K; int gtoff; float scale; };

template <int KIND> DI bool get_unit(CParams& p, const GP& g, int L, UD& u) {
    u.nseg = 1; u.ty = 0; u.A[1] = nullptr; u.B[1] = nullptr; u.lda[1] = 0; u.ldb[1] = 0; u.nt[1] = 0;
    if (KIND == K_UP) { if (L >= 80 * 22) return false; tile_map(L, 80, 22, u.pm, u.pn); u.A[0] = (const char*)(g.A + (size_t)u.pm * 256 * 1024); u.B[0] = (const char*)(g.B + (size_t)u.pn * 256 * 1024); u.lda[0] = u.ldb[0] = 1024; u.nt[0] = 16; return true; }
    if (KIND == K_RES || KIND == K_RESD) { if (L >= 80 * 4) return false; tile_map(L, 80, 4, u.pm, u.pn); u.A[0] = (const char*)(g.A + (size_t)u.pm * 256 * g.K); u.B[0] = (const char*)(g.B + (size_t)u.pn * 256 * g.K); u.lda[0] = u.ldb[0] = g.K; u.nt[0] = g.K / 64; return true; }
    if (KIND == K_SW) { if (L >= 5 * 80) return false; if (L < 320) tile_map(L, 4, 80, u.pm, u.pn); else { u.pm = 4; u.pn = L - 320; }
        u.A[0] = (u.pm < 4) ? (const char*)((const bf16_t*)(p.ws + OFF_WINS) + (size_t)u.pm * 256 * 1024) : (const char*)((const bf16_t*)(p.ws + OFF_WINN) + (size_t)12 * 256 * 1024); u.B[0] = (const char*)((const bf16_t*)(p.ws + P_A) + (size_t)u.pn * 256 * 1024); u.lda[0] = u.ldb[0] = 1024; u.nt[0] = 16; return true; }
    if (KIND == K_IN2) { if (L >= 640 + 320) return false; u.lda[0] = u.ldb[0] = 1024; u.nt[0] = 16; const bf16_t* h2 = (const bf16_t*)(p.ws + P_A);
        if (L < 640) { tile_map(L, 8, 80, u.pm, u.pn); u.ty = 0; u.A[0] = (const char*)((const bf16_t*)(p.ws + OFF_WINS) + (size_t)(4 + u.pm) * 256 * 1024); u.B[0] = (const char*)(h2 + (size_t)u.pn * 256 * 1024); }
        else { tile_map(L - 640, 80, 4, u.pm, u.pn); u.ty = 1; u.A[0] = (const char*)(h2 + (size_t)u.pm * 256 * 1024); u.B[0] = (const char*)((const bf16_t*)(p.ws + OFF_WINN) + (size_t)u.pn * 256 * 1024); }
        return true; }
    if (KIND == K_PL) { if (L >= 80 * 8) return false; tile_map(L, 80, 8, u.pm, u.pn); u.A[0] = (const char*)((const bf16_t*)(p.ws + P_A) + (size_t)u.pm * 256 * 1024); u.B[0] = (const char*)((const bf16_t*)(p.ws + OFF_WINN) + (size_t)(4 + u.pn) * 256 * 1024); u.lda[0] = u.ldb[0] = 1024; u.nt[0] = 16; return true; }
    if (KIND == K_DFT) { if (L >= 160) return false; u.nseg = 2; const bf16_t* gT = (const bf16_t*)(p.ws + P_GT);
        if (L < 128) { const int b = L >> 5, r = L & 31; u.pm = r >> 1; u.pn = r & 1; u.ty = b;
            u.A[0] = (const char*)((const bf16_t*)(p.ws + P_DFTC) + (size_t)u.pm * 256 * 4096); u.A[1] = (const char*)((const bf16_t*)(p.ws + P_DFTS) + (size_t)u.pm * 256 * 4096); u.lda[0] = u.lda[1] = 4096;
            u.B[0] = (const char*)(gT + (size_t)(u.pn * 256) * MT + MCTX + b * 4096); u.B[1] = (const char*)(gT + (size_t)(512 + u.pn * 256) * MT + MCTX + b * 4096); u.ldb[0] = u.ldb[1] = MT; u.nt[0] = u.nt[1] = 64; }
        else { const int j = L - 128; const int b = j >> 1; u.pm = 0; u.pn = j & 1; u.ty = 4 + b;
            u.A[0] = (const char*)(p.ws + OFF_C256); u.A[1] = (const char*)(p.ws + OFF_S256); u.lda[0] = u.lda[1] = 4096;
            u.B[0] = (const char*)(gT + (size_t)(u.pn * 256) * MT + b * 256); u.B[1] = (const char*)(gT + (size_t)(512 + u.pn * 256) * MT + b * 256); u.ldb[0] = u.ldb[1] = MT; u.nt[0] = u.nt[1] = 4; }
        return true; }
    if (KIND == K_PROJ) { if (L >= 80 * 4) return false; tile_map(L, 80, 4, u.pm, u.pn); u.nseg = 2;
        u.A[0] = (const char*)((const bf16_t*)(p.ws + P_FM) + (size_t)u.pm * 256 * 512); u.B[0] = (const char*)((const bf16_t*)(p.ws + OFF_WPF) + (size_t)u.pn * 256 * 1536); u.lda[0] = 512; u.ldb[0] = 1536; u.nt[0] = 8;
        u.A[1] = (const char*)((const bf16_t*)(p.ws + P_R) + (size_t)u.pm * 256 * 1024); u.B[1] = (const char*)((const bf16_t*)(p.ws + OFF_WPF) + (size_t)u.pn * 256 * 1536 + 512); u.lda[1] = 1024; u.ldb[1] = 1536; u.nt[1] = 16; return true; }
    return false;
}
DI u32x4 pack8(const f32x4& a, const f32x4& b) { u32x4 o; o[0] = pk2(a[0], a[1]); o[1] = pk2(a[2], a[3]); o[2] = pk2(b[0], b[1]); o[3] = pk2(b[2], b[3]); return o; }
template <int KIND> DI void gemm_mid(CParams& p, f32x4 (&acc)[2][2][4][2], const UD& u, int wr, int wc, int fr, int fq) {
    if (KIND == K_PROJ) {
        const char* zg = (const char*)(p.ws + P_ZG);
        const unsigned o0 = (unsigned)(((u.pm * 256 + wr * 64 + fr) * 2048 + u.pn * 256 + wc * 32 + 8 * fq) * 2);
#pragma unroll
        for (int ai = 0; ai < 2; ++ai)
#pragma unroll
            for (int m = 0; m < 4; ++m) {
#pragma unroll
                for (int bj = 0; bj < 2; ++bj) { const unsigned o = opq(o0 + (unsigned)(((ai * 128 + m * 16) * 2048 + bj * 128) * 2));
                    const u32x4 ga = *(const u32x4*)(zg + o), gb = *(const u32x4*)(zg + o + 2048);
#pragma unroll
                    for (int e = 0; e < 4; ++e) { const float a0 = bflo(ga[e]), a1 = bfhi(ga[e]), b0 = bflo(gb[e]), b1 = bfhi(gb[e]);
                        acc[ai][bj][m][e >> 1][(e & 1) * 2] *= (1.f + __expf(-b0)) * __builtin_amdgcn_rcpf(1.f + __expf(-a0)); acc[ai][bj][m][e >> 1][(e & 1) * 2 + 1] *= (1.f + __expf(-b1)) * __builtin_amdgcn_rcpf(1.f + __expf(-a1)); }
                    asm volatile("" : "+v"(acc[ai][bj][m][0]), "+v"(acc[ai][bj][m][1]) :: "memory"); } }
    }
}
template <int KIND> DI void gemm_epi(CParams& p, const GP& g, f32x4 (&acc)[2][2][4][2], const UD& u, int wr, int wc, int fr, int fq) {
    const int r0 = u.pm * 256 + wr * 64 + fr, c0 = u.pn * 256 + wc * 32 + 8 * fq;
    if (KIND == K_UP) {
        bf16_t* act = (bf16_t*)(p.ws + P_ACT);
#pragma unroll
        for (int ai = 0; ai < 2; ++ai)
#pragma unroll
            for (int m = 0; m < 4; ++m) { f32x4 a, b;
#pragma unroll
                for (int e = 0; e < 4; ++e) { a[e] = siluf_(acc[ai][0][m][0][e]) * acc[ai][1][m][0][e]; b[e] = siluf_(acc[ai][0][m][1][e]) * acc[ai][1][m][1][e]; }
                *(u32x4*)(act + (size_t)(r0 + ai * 128 + m * 16) * DFF + u.pn * 128 + wc * 32 + 8 * fq) = pack8(a, b); }
    } else if (KIND == K_RES || KIND == K_RESD) {
        const float* gt = (const float*)(p.ws + OFF_MOD) + (u.pm < 16 ? 4 : ((u.pm - 16) >> 4)) * 9216 + g.gtoff;
#pragma unroll
        for (int bj = 0; bj < 2; ++bj)
#pragma unroll
            for (int n = 0; n < 2; ++n) { const int col = c0 + bj * 128 + 4 * n; const f32x4 gv = *(const f32x4*)(gt + col) * g.scale;
#pragma unroll
                for (int ai = 0; ai < 2; ++ai)
#pragma unroll
                    for (int m = 0; m < 4; ++m) { float* xp = p.out + (size_t)(r0 + ai * 128 + m * 16) * 1024 + col; f32x4 xv = *(const f32x4*)xp; xv += gv * acc[ai][bj][m][n]; *(f32x4*)xp = xv; } }
    } else if (KIND == K_SW && u.pm == 4) {
        if (wr == 0) { float* alrT = (float*)(p.ws + P_ALR);
#pragma unroll
            for (int m = 0; m < 2; ++m)
#pragma unroll
                for (int bj = 0; bj < 2; ++bj)
#pragma unroll
                    for (int n = 0; n < 2; ++n) *(f32x4*)(alrT + (size_t)(m * 16 + fr) * MT + c0 + bj * 128 + 4 * n) = acc[0][bj][m][n];
        }
    } else if (KIND == K_SW || (KIND == K_IN2 && u.ty == 0)) {
        bf16_t* dst = (KIND == K_SW) ? (bf16_t*)(p.ws + P_GT) : (bf16_t*)(p.ws + P_QKV);
#pragma unroll
        for (int ai = 0; ai < 2; ++ai)
#pragma unroll
            for (int m = 0; m < 4; ++m)
#pragma unroll
                for (int bj = 0; bj < 2; ++bj) *(u32x4*)(dst + (size_t)(r0 + ai * 128 + m * 16) * MT + c0 + bj * 128) = pack8(acc[ai][bj][m][0], acc[ai][bj][m][1]);
    } else if (KIND == K_IN2) {
        { bf16_t* zr = (bf16_t*)(p.ws + P_R);
#pragma unroll
            for (int ai = 0; ai < 2; ++ai)
#pragma unroll
                for (int m = 0; m < 4; ++m)
#pragma unroll
                    for (int bj = 0; bj < 2; ++bj) *(u32x4*)(zr + (size_t)(r0 + ai * 128 + m * 16) * 1024 + c0 + bj * 128) = pack8(acc[ai][bj][m][0], acc[ai][bj][m][1]);
        }
    } else if (KIND == K_PL) {
        bf16_t* zg = (bf16_t*)(p.ws + P_ZG);
#pragma unroll
        for (int ai = 0; ai < 2; ++ai)
#pragma unroll
            for (int m = 0; m < 4; ++m)
#pragma unroll
                for (int bj = 0; bj < 2; ++bj) *(u32x4*)(zg + (size_t)(r0 + ai * 128 + m * 16) * 2048 + c0 + bj * 128) = pack8(acc[ai][bj][m][0], acc[ai][bj][m][1]);
    } else if (KIND == K_DFT) {
        bf16_t* fm = (bf16_t*)(p.ws + P_FM); const int tok0 = u.ty < 4 ? MCTX + u.ty * 4096 : (u.ty - 4) * 256; const float sc = u.ty < 4 ? 0.001381067932004975f : 0.005524271728019903f;
#pragma unroll
        for (int ai = 0; ai < 2; ++ai)
#pragma unroll
            for (int m = 0; m < 4; ++m)
#pragma unroll
                for (int bj = 0; bj < 2; ++bj) *(u32x4*)(fm + (size_t)(tok0 + r0 + ai * 128 + m * 16) * 512 + c0 + bj * 128) = pack8(acc[ai][bj][m][0] * sc, acc[ai][bj][m][1] * sc);
    } else if (KIND == K_PROJ) {
        const char* zg = (const char*)(p.ws + P_ZG); char* mg = (char*)(p.ws + P_A);
        const unsigned o0 = (unsigned)((r0 * 2048 + c0) * 2), q0 = (unsigned)((r0 * 1024 + c0) * 2);
#pragma unroll
        for (int ai = 0; ai < 2; ++ai)
#pragma unroll
            for (int m = 0; m < 4; ++m) {
#pragma unroll
                for (int bj = 0; bj < 2; ++bj) { const unsigned o = opq(o0 + (unsigned)(((ai * 128 + m * 16) * 2048 + bj * 128) * 2)), q = opq(q0 + (unsigned)(((ai * 128 + m * 16) * 1024 + bj * 128) * 2));
                    const u32x4 gb = *(const u32x4*)(zg + o + 2048); f32x4 a, b;
#pragma unroll
                    for (int e = 0; e < 2; ++e) { a[2 * e] = acc[ai][bj][m][0][2 * e] * __builtin_amdgcn_rcpf(1.f + __expf(-bflo(gb[e]))); a[2 * e + 1] = acc[ai][bj][m][0][2 * e + 1] * __builtin_amdgcn_rcpf(1.f + __expf(-bfhi(gb[e])));
                        b[2 * e] = acc[ai][bj][m][1][2 * e] * __builtin_amdgcn_rcpf(1.f + __expf(-bflo(gb[2 + e]))); b[2 * e + 1] = acc[ai][bj][m][1][2 * e + 1] * __builtin_amdgcn_rcpf(1.f + __expf(-bfhi(gb[2 + e]))); }
                    *(u32x4*)(mg + q) = pack8(a, b); }
                asm volatile("" ::: "memory"); }
    }
}

template <int KIND> DI void gemm_phase(LAS unsigned char* lds, CParams& p, const GP g) {
    const int tid = TID(), wid = __builtin_amdgcn_readfirstlane(tid >> 6), lane = tid & 63, wr = wid >> 2, wc = wid & 3, fr = lane & 15, fq = lane >> 4;
    constexpr int LDA = KLd<KIND>::A, LDB = KLd<KIND>::B;
    int RA2[2], C2[2]; unsigned voffA[2], voffB[2];
#pragma unroll
    for (int i = 0; i < 2; ++i) { int R, C; stage_rc(tid * 16 + i * 8192, R, C); RA2[i] = R * 2; C2[i] = C * 2; voffA[i] = (unsigned)(R * 2 * LDA + C * 2); voffB[i] = (unsigned)(((R & ~31) + perm32(R & 31)) * 2 * LDB + C * 2); }
    const unsigned ldsw = (unsigned)wid * 1024u;
    const int aoff = lds_byte(wr * 64 + fr, fq * 8), boff = lds_byte(wc * 32 + fr, fq * 8);
#define G_SA(b, h) (((b) * 2 + (h)) * HTB)
#define G_SB(b, h) ((4 + (b) * 2 + (h)) * HTB)
#define G_STAGE_A(bufoff, gbase, ld) do { _Pragma("unroll") for (int _i = 0; _i < 2; ++_i) { unsigned _o; if (LDA != 0) { _o = voffA[_i]; asm volatile("" : "+v"(_o)); } else asm volatile("v_mad_u32_u24 %0, %1, %2, %3" : "=v"(_o) : "v"(RA2[_i]), "s"(ld), "v"(C2[_i])); \
        __builtin_amdgcn_global_load_lds((const unsigned*)((const char*)(gbase) + _o), (LAS unsigned*)(lds + (bufoff) + ldsw + _i * 8192), 16, 0, 0); } } while (0)
#define G_STAGE_B(bufoff, gbase) do { _Pragma("unroll") for (int _i = 0; _i < 2; ++_i) { unsigned _o = voffB[_i]; asm volatile("" : "+v"(_o)); \
        __builtin_amdgcn_global_load_lds((const unsigned*)((const char*)(gbase) + _o), (LAS unsigned*)(lds + (bufoff) + ldsw + _i * 8192), 16, 0, 0); } } while (0)
#define G_LDA(dst, b, h) do { _Pragma("unroll") for (int m = 0; m < 4; ++m) _Pragma("unroll") for (int k = 0; k < 2; ++k) dst[m][k] = *(const LAS bf16x8*)(lds + G_SA(b, h) + aoff + m * 2048 + k * 1024); } while (0)
#define G_LDB(dst, b, h) do { _Pragma("unroll") for (int n = 0; n < 2; ++n) _Pragma("unroll") for (int k = 0; k < 2; ++k) dst[n][k] = *(const LAS bf16x8*)(lds + G_SB(b, h) + boff + n * 2048 + k * 1024); } while (0)
#define G_MMA(ai, bj, At, Bt) do { __builtin_amdgcn_s_setprio(1); _Pragma("unroll") for (int m = 0; m < 4; ++m) _Pragma("unroll") for (int n = 0; n < 2; ++n) _Pragma("unroll") for (int k = 0; k < 2; ++k) \
        acc[ai][bj][m][n] = __builtin_amdgcn_mfma_f32_16x16x32_bf16(Bt[n][k], At[m][k], acc[ai][bj][m][n], 0, 0, 0); __builtin_amdgcn_s_setprio(0); } while (0)
#define G_WAIT_V(n) asm volatile("s_waitcnt vmcnt(" #n ")" ::: "memory")
#define G_WAIT_L(n) asm volatile("s_waitcnt lgkmcnt(" #n ")" ::: "memory")
#define G_BAR __builtin_amdgcn_s_barrier()
#define G_SCHED __builtin_amdgcn_sched_barrier(0)
    const int G = gridDim.x, cblk = BID();
    UD cu; int ui = 0;
    if (!get_unit<KIND>(p, g, cblk, cu)) return;
    f32x4 acc[2][2][4][2];
#pragma unroll
    for (int a = 0; a < 2; ++a)
#pragma unroll
        for (int b = 0; b < 2; ++b)
#pragma unroll
            for (int m = 0; m < 4; ++m)
#pragma unroll
                for (int n = 0; n < 2; ++n) acc[a][b][m][n] = (f32x4){0.f, 0.f, 0.f, 0.f};
    bf16x8 At[4][2], B0[2][2], B1[2][2];
    const char* cA = cu.A[0]; const char* cB = cu.B[0]; int clda = (LDA != 0) ? LDA : cu.lda[0], nt = cu.nt[0];
    {   const size_t hA = (size_t)clda * 256, hB = (size_t)LDB * 256;
        G_STAGE_B(G_SB(0, 0), cB); G_STAGE_A(G_SA(0, 0), cA, clda); G_STAGE_B(G_SB(0, 1), cB + hB); G_STAGE_A(G_SA(0, 1), cA + hA, clda);
        if (wr == 1) G_BAR;
        G_WAIT_V(4); G_BAR;
        G_STAGE_B(G_SB(1, 0), cB + 128); G_STAGE_A(G_SA(1, 0), cA + 128, clda); G_STAGE_B(G_SB(1, 1), cB + hB + 128);
        G_WAIT_V(6); G_BAR; }
    constexpr int NSEG = (KIND == K_DFT || KIND == K_PROJ) ? 2 : 1;
    for (;;) {
        bool has_next = true;
#pragma unroll
        for (int sg = 0; sg < NSEG; ++sg) {
            const char* nA; const char* nB; int nlda, nnt;
            if (sg + 1 < NSEG) { nA = cu.A[1]; nB = cu.B[1]; nlda = cu.lda[1]; nnt = cu.nt[1]; }
            else { UD nu; has_next = get_unit<KIND>(p, g, (ui + 1) * G + cblk, nu);
                if (has_next) { nA = nu.A[0]; nB = nu.B[0]; nlda = nu.lda[0]; nnt = nu.nt[0]; } else { nA = cA; nB = cB; nlda = clda; nnt = nt; } }
            if (LDA != 0) nlda = LDA;
            const size_t chA = (size_t)clda * 256;
            for (int t = 0; t < nt; t += 2) {
                const bool last = (t == nt - 2);
                const char* a1 = cA + (size_t)(t + 1) * 128;
                const char* a2 = last ? nA : cA + (size_t)(t + 2) * 128; const char* b2 = last ? nB : cB + (size_t)(t + 2) * 128;
                const int lda2 = (LDA != 0) ? LDA : (last ? nlda : clda); const size_t hA2 = (size_t)lda2 * 256, hB2 = (size_t)LDB * 256;
                const char* a3 = a2 + 128; const char* b3 = b2 + 128;
                G_LDB(B0, 0, 0); G_SCHED; G_LDA(At, 0, 0); G_STAGE_A(G_SA(1, 1), a1 + chA, clda);
                G_WAIT_L(8); G_BAR; G_WAIT_L(0); G_MMA(0, 0, At, B0); G_BAR; G_SCHED;
                G_LDB(B1, 0, 1); G_STAGE_B(G_SB(0, 0), b2);
                G_BAR; G_WAIT_L(0); G_MMA(0, 1, At, B1); G_BAR;
                G_LDA(At, 0, 1); G_STAGE_A(G_SA(0, 0), a2, lda2);
                G_BAR; G_WAIT_L(0); G_MMA(1, 0, At, B0); G_BAR; G_SCHED;
                G_STAGE_B(G_SB(0, 1), b2 + hB2);
                G_WAIT_V(6); G_BAR; G_MMA(1, 1, At, B1); G_BAR;
                G_LDB(B0, 1, 0); G_SCHED; G_LDA(At, 1, 0); G_STAGE_A(G_SA(0, 1), a2 + hA2, lda2);
                G_WAIT_L(8); G_BAR; G_WAIT_L(0); G_MMA(0, 0, At, B0); G_BAR; G_SCHED;
                G_LDB(B1, 1, 1); G_STAGE_B(G_SB(1, 0), b3);
                G_BAR; G_WAIT_L(0); G_MMA(0, 1, At, B1); G_BAR;
                G_LDA(At, 1, 1); G_STAGE_A(G_SA(1, 0), a3, lda2);
                G_BAR; G_WAIT_L(0); G_MMA(1, 0, At, B0); G_BAR; G_SCHED;
                G_STAGE_B(G_SB(1, 1), b3 + hB2);
                G_WAIT_V(6); G_BAR; G_MMA(1, 1, At, B1); G_BAR;
            }
            if (sg + 1 < NSEG) gemm_mid<KIND>(p, acc, cu, wr, wc, fr, fq); else gemm_epi<KIND>(p, g, acc, cu, wr, wc, fr, fq);
            cA = nA; cB = nB; clda = nlda; nt = nnt;
        }
        if (!has_next) break;
#pragma unroll
        for (int a = 0; a < 2; ++a)
#pragma unroll
            for (int b = 0; b < 2; ++b)
#pragma unroll
                for (int m = 0; m < 4; ++m)
#pragma unroll
                    for (int n = 0; n < 2; ++n) acc[a][b][m][n] = (f32x4){0.f, 0.f, 0.f, 0.f};
        ++ui; get_unit<KIND>(p, g, ui * G + cblk, cu);
    }
    G_WAIT_V(0);
    if (wr == 0) G_BAR;
    G_BAR;
}

constexpr int QS = 136, KS = 40;
#define MFMA32(a, b, c) __builtin_amdgcn_mfma_f32_32x32x16_bf16((a), (b), (c), 0, 0, 0)
DI bf16x8 packS(const f32x16& x, int kk) { u32x4 o; o[0] = pk2(x[8 * kk], x[8 * kk + 1]); o[1] = pk2(x[8 * kk + 2], x[8 * kk + 3]); o[2] = pk2(x[8 * kk + 4], x[8 * kk + 5]); o[3] = pk2(x[8 * kk + 6], x[8 * kk + 7]); return __builtin_bit_cast(bf16x8, o); }
template <int MODE, int DIR> DI void gla_phase(LAS unsigned char* lds, CParams& p) {
    LAS float* a_s = (LAS float*)lds; LAS float* eb_s = (LAS float*)(lds + 8192); LAS float* red = (LAS float*)(lds + 10240); LAS float* dsum = (LAS float*)(lds + 12288);
    LAS bf16_t* qts = (LAS bf16_t*)(lds + 14336); LAS bf16_t* kts = (LAS bf16_t*)(lds + 49152); LAS bf16_t* khs = (LAS bf16_t*)(lds + 83968);
    const int tid = TID(), w = tid >> 6, lane = tid & 63, r32 = lane & 31, hh = lane >> 5, cg = tid >> 7, c = tid & 127;
    const bf16_t* qkvT = (const bf16_t*)(p.ws + P_QKV); const float* alr = (const float*)(p.ws + P_ALR); bf16_t* Ub = (bf16_t*)(p.ws + P_U); float* Dbuf = (float*)(p.ws + OFF_DBUF);
    bf16_t* of = (bf16_t*)(p.ws + P_A); bf16_t* zr = (bf16_t*)(p.ws + P_R);
    const int nitems = (MODE == 1) ? 256 : 320; constexpr int dir = DIR;
    for (int it = BID(); it < nitems; it += gridDim.x) {
        int h, b, isctx, m0, slot;
        if (MODE == 1) { const int sg = it & 15; h = (it >> 4) & 3; b = it >> 6; isctx = 0; slot = ((b * 4 + h) * 2 + dir) * 16 + sg; m0 = MCTX + 4096 * b + 256 * (dir ? 15 - sg : sg); }
        else {
            if (it < 64) { isctx = 1; b = it >> 2; h = it & 3; m0 = 256 * b; slot = -1; }
            else { const int j = it - 64; const int sg = j & 15; h = (j >> 4) & 3; b = j >> 6; isctx = 0; slot = ((b * 4 + h) * 2 + dir) * 16 + sg; m0 = MCTX + 4096 * b + 256 * (dir ? 15 - sg : sg); } }
        const float* walpha = p.in[dir ? 16 : 14]; const float* balpha = p.in[dir ? 17 : 15];
        f32x16 S[4];
        if (MODE != 1 && slot >= 0) {
#pragma unroll
            for (int d = 0; d < 4; ++d)
#pragma unroll
                for (int q = 0; q < 16; ++q) { const char* up = (const char*)(Ub + ((size_t)slot * 8 + __builtin_amdgcn_readfirstlane(w)) * 4096 + (16 * d + q) * 64); S[d][q] = bf2f(*(const bf16_t*)(up + opq((unsigned)lane * 2u))); }
        } else {
#pragma unroll
            for (int d = 0; d < 4; ++d)
#pragma unroll
                for (int q = 0; q < 16; ++q) S[d][q] = 0.f;
        }
        float dacc = 0.f;
#pragma unroll 1
        for (int g = 0; g < 2; ++g) {
            const int gbase = m0 + 128 * (dir ? 1 - g : g);
            { const int r = tid >> 5, t4 = tid & 31; *(LAS f32x4*)(a_s + r * 128 + 4 * t4) = *(const f32x4*)(alr + (size_t)(dir * 16 + r) * MT + gbase + 4 * t4); }
            __syncthreads();
            {
                float wv[16];
#pragma unroll
                for (int r = 0; r < 16; ++r) wv[r] = walpha[r * 512 + h * 128 + c];
                const float bias = balpha[h * 128 + c];
                const int ci = dir ? 7 - (4 * g + cg) : 4 * g + cg; const int tb = m0 + 32 * ci; const int loc = tb - gbase;
                u32x4 kq[4], qq[4];
                const char* kbase = (const char*)(qkvT + (size_t)(512 + h * 128) * MT + tb); const char* qbase = (const char*)(qkvT + (size_t)(h * 128) * MT + tb);
                const unsigned coff = opq((unsigned)c * (unsigned)(MT * 2));
#pragma unroll
                for (int i = 0; i < 4; ++i) { kq[i] = *(const u32x4*)(kbase + coff + 16 * i); if (MODE != 1) qq[i] = *(const u32x4*)(qbase + coff + 16 * i); }
                float run = 0.f;
#pragma unroll
                for (int i4s = 0; i4s < 4; ++i4s) { const int i4 = DIR ? 3 - i4s : i4s; float khv[8];
#pragma unroll
                    for (int hs = 0; hs < 2; ++hs) { const int hf = DIR ? 1 - hs : hs; f32x4 xv = {bias, bias, bias, bias};
#pragma unroll
                        for (int r = 0; r < 16; ++r) xv += *(LAS const f32x4*)(a_s + r * 128 + loc + 8 * i4 + 4 * hf) * wv[r];
#pragma unroll
                        for (int es = 0; es < 4; ++es) { const int e4 = DIR ? 3 - es : es; const int e = 4 * hf + e4; const int i = 8 * i4 + e; const float x = xv[e4];
                            const float ls = fminf(x, 0.f) - __logf(1.f + __expf(-fabsf(x)));
                            run += ls * (1.f / 16.f);
                            const float kv = (e & 1) ? bfhi(kq[i4][e >> 1]) : bflo(kq[i4][e >> 1]);
                            const float kd = kv * __expf(-run); khv[e] = kd;
                            if (MODE != 1) { const float qv = (e & 1) ? bfhi(qq[i4][e >> 1]) : bflo(qq[i4][e >> 1]);
                                const unsigned pq = pk2(qv * __expf(run), kd);
                                qts[(cg * 32 + i) * QS + c] = (bf16_t)(pq & 0xffffu); kts[(cg * 32 + i) * QS + c] = (bf16_t)(pq >> 16); } }
                        asm volatile("" ::: "memory"); }
                    u32x4 kh; kh[0] = pk2(khv[0], khv[1]); kh[1] = pk2(khv[2], khv[3]); kh[2] = pk2(khv[4], khv[5]); kh[3] = pk2(khv[6], khv[7]);
                    *(LAS u32x4*)(khs + (cg * 128 + c) * KS + 8 * i4) = kh; }
                const float tot = run; dacc += tot;
                eb_s[cg * 128 + c] = __expf(tot);
            }
            bf16x8 vnx[2];
            {
                const int ci0 = dir ? 7 - 4 * g : 4 * g; const char* vb0 = (const char*)(qkvT + (size_t)(1024 + h * 256) * MT + m0 + 32 * ci0); const unsigned vo = opq((unsigned)(32 * w + r32) * (unsigned)(MT * 2) + 8u * hh);
#pragma unroll
                for (int kk = 0; kk < 2; ++kk) { const s16x4 lo = *(const s16x4*)(vb0 + vo + 32 * kk), hi = *(const s16x4*)(vb0 + vo + 32 * kk + 16); vnx[kk] = __builtin_shufflevector(lo, hi, 0, 1, 2, 3, 4, 5, 6, 7); } }
            __syncthreads();
#pragma unroll 1
            for (int s = 0; s < 4; ++s) {
                const int ci = dir ? 7 - (4 * g + s) : 4 * g + s; const int tb = m0 + 32 * ci;
                const char* vbase = (const char*)(qkvT + (size_t)(1024 + h * 256) * MT + tb);
                const unsigned voff = opq((unsigned)(32 * w + r32) * (unsigned)(MT * 2) + 8u * hh);
                const char* obase = (const char*)(of + (size_t)tb * 1024 + h * 256); const char* rbase = (const char*)(zr + (size_t)tb * 1024 + h * 256);
                const unsigned ooff = opq((unsigned)((r32 * 1024 + 32 * w + 4 * hh) * 2));
                bf16x8 vf[2]; vf[0] = vnx[0]; vf[1] = vnx[1];
                if (s < 3) { const int cin = dir ? ci - 1 : ci + 1; const char* vbn = vbase + (cin - ci) * 64;
#pragma unroll
                    for (int kk = 0; kk < 2; ++kk) { const s16x4 lo = *(const s16x4*)(vbn + voff + 32 * kk), hi = *(const s16x4*)(vbn + voff + 32 * kk + 16); vnx[kk] = __builtin_shufflevector(lo, hi, 0, 1, 2, 3, 4, 5, 6, 7); } }
                f32x16 O;
                if (MODE != 1) {
                    LAS const bf16_t* kt_ = kts + (s * 32 + r32) * QS; LAS const bf16_t* qt_ = qts + (s * 32 + r32) * QS;
                    f32x16 PT;
#pragma unroll
                    for (int q = 0; q < 16; ++q) { PT[q] = 0.f; O[q] = 0.f; }
#pragma unroll
                    for (int ks = 0; ks < 8; ++ks) { const bf16x8 A = *(LAS const bf16x8*)(kt_ + 16 * ks + 8 * hh), B = *(LAS const bf16x8*)(qt_ + 16 * ks + 8 * hh); PT = MFMA32(A, B, PT); }
                    { const int rl = (int)opq((unsigned)r32) - 4 * hh;
#pragma unroll
                    for (int q = 0; q < 16; ++q) { const int j = 8 * (q >> 2) + (q & 3); const bool keep = dir ? (j >= rl) : (j <= rl); PT[q] = keep ? PT[q] : 0.f; } }
#pragma unroll
                    for (int d = 0; d < 4; ++d)
#pragma unroll
                        for (int kk = 0; kk < 2; ++kk) { const s16x4 lo = *(LAS const s16x4*)(qt_ + 32 * d + 16 * kk + 4 * hh), hi = *(LAS const s16x4*)(qt_ + 32 * d + 16 * kk + 8 + 4 * hh);
                            O = MFMA32(packS(S[d], kk), __builtin_shufflevector(lo, hi, 0, 1, 2, 3, 4, 5, 6, 7), O); }
#pragma unroll
                    for (int kk = 0; kk < 2; ++kk) O = MFMA32(vf[kk], packS(PT, kk), O);
                }
#pragma unroll
                for (int d = 0; d < 4; ++d) {
                    LAS const bf16_t* kh = khs + (s * 128 + 32 * d + r32) * KS;
#pragma unroll
                    for (int kk = 0; kk < 2; ++kk) { const s16x4 lo = *(LAS const s16x4*)(kh + 16 * kk + 4 * hh), hi = *(LAS const s16x4*)(kh + 16 * kk + 8 + 4 * hh);
                        S[d] = MFMA32(__builtin_shufflevector(lo, hi, 0, 1, 2, 3, 4, 5, 6, 7), vf[kk], S[d]); }
#pragma unroll
                    for (int g4 = 0; g4 < 4; ++g4) { const f32x4 ev = *(LAS const f32x4*)(eb_s + s * 128 + 32 * d + 8 * g4 + 4 * hh);
#pragma unroll
                        for (int r = 0; r < 4; ++r) S[d][4 * g4 + r] *= ev[r]; }
                }
                if (MODE == 2) {
#pragma unroll
                    for (int g4 = 0; g4 < 4; ++g4) { u32x2 o2; o2[0] = pk2(O[4 * g4], O[4 * g4 + 1]); o2[1] = pk2(O[4 * g4 + 2], O[4 * g4 + 3]);
                        *(u32x2*)(const_cast<char*>(obase) + ooff + 16 * g4) = o2; }
                }
                if (MODE == 3) {
                    const int par = s & 1; float ov[16]; float ss = 0.f;
#pragma unroll
                    for (int g4 = 0; g4 < 4; ++g4) { const u32x2 f = *(const u32x2*)(obase + ooff + 16 * g4);
                        ov[4 * g4] = O[4 * g4] + bflo(f[0]); ov[4 * g4 + 1] = O[4 * g4 + 1] + bfhi(f[0]); ov[4 * g4 + 2] = O[4 * g4 + 2] + bflo(f[1]); ov[4 * g4 + 3] = O[4 * g4 + 3] + bfhi(f[1]); }
#pragma unroll
                    for (int q = 0; q < 16; ++q) ss += ov[q] * ov[q];
                    ss += __shfl_xor(ss, 32);
                    if (hh == 0) red[(par * 8 + w) * 32 + r32] = ss;
                    __syncthreads();
                    float tot = 0.f;
#pragma unroll
                    for (int w2 = 0; w2 < 8; ++w2) tot += red[(par * 8 + w2) * 32 + r32];
                    const float rinv = rsqrtf(tot * (1.f / 256.f) + 1e-6f);
#pragma unroll
                    for (int g4 = 0; g4 < 4; ++g4) { const int dv0 = h * 256 + 32 * w + 8 * g4 + 4 * hh; const f32x4 gn = *(const f32x4*)(p.in[18] + dv0);
                        char* rp = const_cast<char*>(rbase) + ooff + 16 * g4; const u32x2 rr = *(const u32x2*)rp;
                        u32x2 o2; o2[0] = pk2(ov[4 * g4] * rinv * gn[0] * siluf_(bflo(rr[0])), ov[4 * g4 + 1] * rinv * gn[1] * siluf_(bfhi(rr[0])));
                        o2[1] = pk2(ov[4 * g4 + 2] * rinv * gn[2] * siluf_(bflo(rr[1])), ov[4 * g4 + 3] * rinv * gn[3] * siluf_(bfhi(rr[1])));
                        *(u32x2*)rp = o2; }
                }
            }
        }
        if (MODE == 1) {
#pragma unroll
            for (int d = 0; d < 4; ++d)
#pragma unroll
                for (int q = 0; q < 16; q += 2) { const unsigned u2 = pk2(S[d][q], S[d][q + 1]); char* up = (char*)(Ub + ((size_t)slot * 8 + __builtin_amdgcn_readfirstlane(w)) * 4096 + (16 * d + q) * 64); const unsigned lo = opq((unsigned)lane * 2u);
                    *(bf16_t*)(up + lo) = (bf16_t)(u2 & 0xffffu); *(bf16_t*)(up + 128 + lo) = (bf16_t)(u2 >> 16); }
            dsum[cg * 128 + c] = dacc;
            __syncthreads();
            if (tid < 128) Dbuf[slot * 128 + tid] = __expf(dsum[tid] + dsum[128 + tid] + dsum[256 + tid] + dsum[384 + tid]);
        } else if (isctx) {
            float* so = p.out + (size_t)MT * 1024 + (size_t)dir * 2097152 + (size_t)(b * 4 + h) * 128 * 256;
#pragma unroll
            for (int d = 0; d < 4; ++d)
#pragma unroll
                for (int q = 0; q < 16; ++q) { char* sp = (char*)(so + (size_t)(32 * d + 8 * (q >> 2) + (q & 3)) * 256); *(float*)(sp + opq((unsigned)((4 * hh * 256 + 32 * w + r32) * 4))) = S[d][q]; }
        }
        __syncthreads();
    }
}
DI void gla_pass2(CParams& p) {
    bf16_t* Ub = (bf16_t*)(p.ws + P_U); const float* Dbuf = (const float*)(p.ws + OFF_DBUF);
    for (int gid = BID() * 512 + TID(); gid < 131072; gid += gridDim.x * 512) {
        const int bhd = gid >> 12, rem = gid & 4095, w = rem >> 9, reg = (rem >> 3) & 63, l8 = rem & 7;
        const int d = reg >> 4, q = reg & 15, hh = l8 >> 2; const int dk = 32 * d + 8 * (q >> 2) + 4 * hh + (q & 3), dv0 = 32 * w + ((8 * l8) & 31);
        const int b = bhd >> 3, h = (bhd >> 1) & 3, dir = bhd & 1;
        const float* s0 = p.in[dir ? 3 : 2] + ((size_t)(b * 4 + h) * 128 + dk) * 256 + dv0;
        float cy[8]; { const f32x4 x0 = *(const f32x4*)s0, x1 = *(const f32x4*)(s0 + 4); cy[0] = x0[0]; cy[1] = x0[1]; cy[2] = x0[2]; cy[3] = x0[3]; cy[4] = x1[0]; cy[5] = x1[1]; cy[6] = x1[2]; cy[7] = x1[3]; }
        for (int sg = 0; sg < 16; ++sg) { bf16_t* sp = Ub + ((size_t)(bhd * 16 + sg) * 8 + w) * 4096 + reg * 64 + 8 * l8; const u32x4 u = *(const u32x4*)sp; const float D = Dbuf[(bhd * 16 + sg) * 128 + dk];
            u32x4 o; o[0] = pk2(cy[0], cy[1]); o[1] = pk2(cy[2], cy[3]); o[2] = pk2(cy[4], cy[5]); o[3] = pk2(cy[6], cy[7]); *(u32x4*)sp = o;
#pragma unroll
            for (int e = 0; e < 4; ++e) { cy[2 * e] = D * cy[2 * e] + bflo(u[e]); cy[2 * e + 1] = D * cy[2 * e + 1] + bfhi(u[e]); } }
    }
}


#define XB_TMO      128
#define XB_XCNT(j)  (256  + 64 * (j))
#define XB_XSUB(j)  (1280 + 64 * (j))
#define XB_XGEN(j)  (2304 + 64 * (j))
#define XB_TOP      3328
#define XB_TOPGEN   3392
#define XCD_BAR_WORDS 3456
#define XB_SPIN_CAP (1u << 20)
DI unsigned xb_ld(unsigned* p)              { return __hip_atomic_load(p, __ATOMIC_RELAXED, __HIP_MEMORY_SCOPE_AGENT); }
DI unsigned xb_add(unsigned* p, unsigned v) { return __hip_atomic_fetch_add(p, v, __ATOMIC_RELAXED, __HIP_MEMORY_SCOPE_AGENT); }
DI unsigned xb_xcc_id() { return (unsigned)__builtin_amdgcn_s_getreg((3 << 11) | 20) & 0xFu; }
#define XB_SPIN(cond, bar) do { unsigned _sp = 0; while (cond) { __builtin_amdgcn_s_sleep(1); \
    if ((++_sp & 255u) == 0u) { if (xb_ld(&(bar)[XB_TMO])) break; if (_sp > XB_SPIN_CAP) { atomicAdd(&(bar)[XB_TMO], 1u); break; } } } } while (0)
struct XcdBarrier { unsigned* bar; unsigned x; volatile LAS unsigned* st; };
DI XcdBarrier xcd_barrier_post(unsigned* bar, volatile LAS unsigned* st) {
    XcdBarrier b; b.bar = bar; b.x = xb_xcc_id(); b.st = st;
    if (threadIdx.x == 0) (void)xb_add(&bar[XB_XCNT(b.x)], 1u);
    return b;
}
DI void xcd_barrier_complete(unsigned* bar, unsigned x, unsigned& nloc, unsigned& nx) {
    const unsigned G = gridDim.x * gridDim.y * gridDim.z;
    unsigned sum, cnt, mine, sp = 0u;
    for (;;) {
        sum = 0u; cnt = 0u; mine = 0u;
#pragma unroll
        for (unsigned j = 0; j < 16; ++j) { const unsigned c = xb_ld(&bar[XB_XCNT(j)]); sum += c; cnt += (c > 0u) ? 1u : 0u; mine = (j == x) ? c : mine; }
        if (sum == G) break;
        __builtin_amdgcn_s_sleep(1);
        if ((++sp & 255u) == 0u) { if (xb_ld(&bar[XB_TMO])) break; if (sp > XB_SPIN_CAP) { atomicAdd(&bar[XB_TMO], 1u); break; } }
    }
    nloc = mine > 0u ? mine : 1u; nx = cnt > 0u ? cnt : 1u;
}
DI void xcd_barrier(const XcdBarrier& b) {
    asm volatile("s_waitcnt vmcnt(0)" ::: "memory");
    __syncthreads();
    if (threadIdx.x == 0) {
        unsigned* bar = b.bar;
        __builtin_amdgcn_s_waitcnt(0);
        unsigned nloc = b.st[0], nx = b.st[1];
        if (nloc == 0u) { xcd_barrier_complete(bar, b.x, nloc, nx); b.st[0] = nloc; b.st[1] = nx; }
        const unsigned old = xb_add(&bar[XB_XSUB(b.x)], 1u);
        const unsigned gen = old / nloc;
        if (old + 1u == (gen + 1u) * nloc) {
            __builtin_amdgcn_fence(__ATOMIC_RELEASE, "agent");
            asm volatile("s_waitcnt vmcnt(0)" ::: "memory");
            const unsigned og = xb_add(&bar[XB_TOP], 1u);
            const unsigned tg = og / nx;
            if (og + 1u == (tg + 1u) * nx) xb_add(&bar[XB_TOPGEN], 1u);
            else XB_SPIN(xb_ld(&bar[XB_TOPGEN]) == tg, bar);
            __builtin_amdgcn_fence(__ATOMIC_ACQUIRE, "agent");
            xb_add(&bar[XB_XGEN(b.x)], 1u);
            asm volatile("s_waitcnt vmcnt(0)" ::: "memory");
        } else {
            XB_SPIN(xb_ld(&bar[XB_XGEN(b.x)]) == gen, bar);
            __builtin_amdgcn_fence(__ATOMIC_ACQUIRE, "agent");
            asm volatile("s_waitcnt vmcnt(0)" ::: "memory");
        }
    }
    __syncthreads();
}

__global__ void __launch_bounds__(512, 2) fwd_megakernel(Params p_arg) {
    extern __shared__ __attribute__((aligned(16))) unsigned char shm[];
    LAS unsigned char* lds = (LAS unsigned char*)shm;
    cg::grid_group grid = cg::this_grid();
    volatile LAS unsigned* xst = (volatile LAS unsigned*)(lds + 131072);
    if (threadIdx.x == 0) { xst[0] = 0u; xst[1] = 0u; }
    __syncthreads();
    const XcdBarrier xb = xcd_barrier_post((unsigned*)(p_arg.ws + OFF_BAR), xst);
    const int nseq = p_arg.nseq;
    for (int si = 0; si < nseq; ++si) {
        unsigned long long kp = (unsigned long long)__builtin_amdgcn_kernarg_segment_ptr(); asm volatile("" : "+s"(kp));
        CParams& p = *(CParams*)kp;
        const int ph = p.seq[si];
        const bf16_t* hA = (const bf16_t*)(p.ws + P_A);
        switch (ph) {
        case 0: if (PH_ON(0)) prep_phase(lds, p); break;
        case 1: if (PH_ON(1)) modreduce_phase(p); break;
        case 2: if (PH_ON(2)) norm_phase<0>(p); break;
        case 3: case 18: if (PH_ON(3)) { GP g{hA, (const bf16_t*)(p.ws + OFF_WUP), 1024, 0, 0.f}; gemm_phase<K_UP>(lds, p, g); } break;
        case 4: case 19: if (PH_ON(4)) { GP g{(const bf16_t*)(p.ws + P_ACT), (const bf16_t*)(p.ws + OFF_WDN), DFF, ph == 4 ? 2048 : 8192, 0.5f}; gemm_phase<K_RESD>(lds, p, g); } break;
        case 5: if (PH_ON(5)) { norm_phase<1>(p); dftgen_phase(lds, p); } break;
        case 6: if (PH_ON(6)) { GP g{nullptr, nullptr, 1024, 0, 0.f}; gemm_phase<K_SW>(lds, p, g); } break;
        case 7: if (PH_ON(7)) { GP g{nullptr, nullptr, 0, 0, 0.f}; gemm_phase<K_DFT>(lds, p, g);
                  if (gridDim.x > 160) { if (BID() >= 160) conv_ffn((LAS float*)lds, p, 1, BID() - 160, gridDim.x - 160); } else conv_ffn((LAS float*)lds, p, 1, BID(), gridDim.x); } break;
        case 8: if (PH_ON(8)) { GP g{nullptr, nullptr, 1024, 0, 0.f}; gemm_phase<K_IN2>(lds, p, g); } break;
        case 9: if (PH_ON(9)) { gla_phase<1, 0>(lds, p); gla_phase<1, 1>(lds, p); } break;
        case 10: if (PH_ON(10)) gla_pass2(p); break;
        case 11: if (PH_ON(11)) gla_phase<2, 0>(lds, p); break;
        case 12: if (PH_ON(12)) gla_phase<3, 1>(lds, p); break;
        case 13: if (PH_ON(13)) norm_phase<1>(p); break;
        case 14: if (PH_ON(14)) { GP g{nullptr, nullptr, 1024, 0, 0.f}; gemm_phase<K_PL>(lds, p, g); } break;
        case 15: if (PH_ON(15)) { GP g{nullptr, nullptr, 0, 0, 0.f}; gemm_phase<K_PROJ>(lds, p, g); } break;
        case 16: if (PH_ON(16)) { GP g{hA, (const bf16_t*)(p.ws + OFF_WOUT), 1024, 5120, 1.f}; gemm_phase<K_RES>(lds, p, g); } break;
        case 17: if (PH_ON(17)) norm_phase<2>(p); break;
        case 20: if (PH_ON(20)) norm_phase<3>(p); break;
        default: break;
        }
        if (si + 1 < nseq) { if (si == 0) grid.sync(); else xcd_barrier(xb); }
    }
}

extern "C" void kernel_launch(void* const* d_in, const int* in_sizes, int n_in, void* d_out, int out_size, void* d_ws, size_t ws_size, hipStream_t stream) {
    static int grid_blocks = 0;
    if (grid_blocks == 0) {
        if (n_in != 27 || ws_size < WS_NEED) { fprintf(stderr, "kernel_launch: unexpected n_in %d or ws_size %zu (need %zu)\n", n_in, ws_size, (size_t)WS_NEED); grid_blocks = -1; return; }
        int dev = 0, cus = 0, per_cu = 0;
        hipGetDevice(&dev); hipDeviceGetAttribute(&cus, hipDeviceAttributeMultiprocessorCount, dev);
        if (hipFuncSetAttribute((const void*)fwd_megakernel, hipFuncAttributeMaxDynamicSharedMemorySize, LDS_BYTES) != hipSuccess) { fprintf(stderr, "kernel_launch: hipFuncSetAttribute failed\n"); grid_blocks = -1; return; }
        if (hipOccupancyMaxActiveBlocksPerMultiprocessor(&per_cu, (const void*)fwd_megakernel, 512, LDS_BYTES) != hipSuccess || per_cu < 1) { fprintf(stderr, "kernel_launch: occupancy query failed (%d)\n", per_cu); grid_blocks = -1; return; }
        grid_blocks = cus;
        if (grid_blocks > cus * per_cu) grid_blocks = cus * per_cu;
    }
    if (grid_blocks < 0) return;
    Params p{};
    for (int i = 0; i < 27; ++i) p.in[i] = (const float*)d_in[i];
    p.out = (float*)d_out; p.ws = (unsigned char*)d_ws;
#ifndef PROBE_DUP
#define PROBE_DUP
#endif
    const int dup[] = {-1, PROBE_DUP};
    int n = 0;
    for (int ph = 0; ph < NPHASE; ++ph) { p.seq[n++] = ph; for (unsigned k = 1; k < sizeof(dup) / sizeof(int); ++k) if (dup[k] == ph) p.seq[n++] = ph; }
    if (hipMemsetAsync((unsigned char*)d_ws + OFF_BAR, 0, XCD_BAR_WORDS * 4, stream) != hipSuccess) { fprintf(stderr, "kernel_launch: memset of barrier words failed\n"); return; }
#if MULTI_LAUNCH
    for (int i = 0; i < n; ++i) { Params q = p; q.nseq = 1; q.seq[0] = p.seq[i]; for (int k = 1; k < 47; ++k) q.seq[k] = 0; hipLaunchKernelGGL(fwd_megakernel, dim3(grid_blocks), dim3(512), LDS_BYTES, stream, q); }
#else
    p.nseq = n;
    void* args[] = {&p};
    hipError_t e = hipLaunchCooperativeKernel((const void*)fwd_megakernel, dim3(grid_blocks), dim3(512), args, LDS_BYTES, stream);
    if (e != hipSuccess) fprintf(stderr, "kernel_launch: cooperative launch failed: %s (grid %d)\n", hipGetErrorString(e), grid_blocks);
#endif
}
```

```cpp
#include <hip/hip_runtime.h>
#include <hip/hip_cooperative_groups.h>
#include <cstdio>
namespace cg = cooperative_groups;

#ifndef MULTI_LAUNCH
#define MULTI_LAUNCH 0
#endif

#ifdef ONLY
#define PH_ON(n) ((n)==ONLY)
#else
#define PH_ON(n) 1
#endif
#define DI __device__ __forceinline__
#define LAS __attribute__((address_space(3)))
typedef unsigned short bf16_t;
typedef short bf16x8 __attribute__((ext_vector_type(8)));
typedef short s16x4 __attribute__((ext_vector_type(4)));
typedef float f32x2 __attribute__((ext_vector_type(2)));
typedef float f32x4 __attribute__((ext_vector_type(4)));
typedef float f32x16 __attribute__((ext_vector_type(16)));
typedef unsigned u32x2 __attribute__((ext_vector_type(2)));
typedef unsigned u32x4 __attribute__((ext_vector_type(4)));
typedef __bf16 bf2_t __attribute__((ext_vector_type(2)));

constexpr int MT = 20480, MCTX = 4096, DM = 1024, DFF = 2816;
constexpr size_t MiB = 1048576;
constexpr size_t OFF_WUP = 0, OFF_WDN = 11 * MiB, OFF_WINS = 16 * MiB + MiB / 2, OFF_WINN = 22 * MiB + MiB / 2, OFF_WPF = 29 * MiB, OFF_WPG = 30 * MiB,
                 OFF_WOUT = 32 * MiB, OFF_SMALL = 34 * MiB, POOL = 36 * MiB;
constexpr size_t OFF_MOD = OFF_SMALL, OFF_DBUF = OFF_SMALL + 256 * 1024;
constexpr size_t P_A = POOL, P_A1 = POOL + 40 * MiB, P_ACT = POOL + 80 * MiB, P_QKV = POOL + 80 * MiB, P_R = POOL + 160 * MiB, P_ALR = POOL + 200 * MiB, P_FM = POOL + 203 * MiB,
                 P_U = POOL + 223 * MiB, P_GT = POOL + 255 * MiB, P_DFTC = POOL + 295 * MiB, P_DFTS = POOL + 303 * MiB, P_STASH = POOL + 311 * MiB, OFF_C256 = POOL + 327 * MiB, OFF_S256 = POOL + 328 * MiB,
                 P_ZG = POOL + 255 * MiB;
constexpr size_t WS_NEED = 384 * MiB;
constexpr int LDS_BYTES = 131072 + 16;
constexpr size_t OFF_BAR = OFF_SMALL + MiB;
constexpr int NPHASE = 21;

struct Params { const float* in[27]; float* out; unsigned char* ws; int nseq; int seq[46]; unsigned amp; };
typedef const __attribute__((address_space(4))) Params CParams;

DI unsigned opq(unsigned o) { asm volatile("" : "+v"(o)); return o; }
DI int TID() { return (int)opq(__builtin_amdgcn_workitem_id_x()); }
DI int BID() { unsigned b = __builtin_amdgcn_workgroup_id_x(); asm volatile("" : "+s"(b)); return (int)b; }
DI unsigned pk2(float a, float b) { f32x2 v = {a, b}; bf2_t r = __builtin_convertvector(v, bf2_t); return __builtin_bit_cast(unsigned, r); }
DI float bflo(unsigned u) { return __uint_as_float(u << 16); }
DI float bfhi(unsigned u) { return __uint_as_float(u & 0xffff0000u); }
DI float bf2f(bf16_t x) { return __uint_as_float(((unsigned)x) << 16); }
DI float siluf_(float x) { return x * __builtin_amdgcn_rcpf(1.f + __expf(-x)); }
DI int modv(int m) { return m < MCTX ? 4 : ((m - MCTX) >> 12); }

DI void tr_tile(LAS float* tl, const float* src, int ld, int k0, int c0, bf16_t* dst, int ldd, int r0, float scale) {
    const int tid = TID();
    { const int i = tid >> 4, j4 = tid & 15;
#pragma unroll
      for (int h = 0; h < 2; ++h) { const f32x4 v = *(const f32x4*)(src + (size_t)(k0 + i + 32 * h) * ld + c0 + 4 * j4); LAS float* d = tl + (i + 32 * h) * 65 + 4 * j4; d[0] = v[0]; d[1] = v[1]; d[2] = v[2]; d[3] = v[3]; } }
    __syncthreads();
    { const int n = tid >> 3, kk = tid & 7; LAS const float* s = tl + (8 * kk) * 65 + n;
      u32x4 o; o[0] = pk2(s[0] * scale, s[65] * scale); o[1] = pk2(s[130] * scale, s[195] * scale); o[2] = pk2(s[260] * scale, s[325] * scale); o[3] = pk2(s[390] * scale, s[455] * scale);
      *(u32x4*)(dst + (size_t)(r0 + n) * ldd + k0 + 8 * kk) = o; }
    __syncthreads();
}
DI void conv_ffn(LAS float* tl, CParams& p, int which, int first, int stride) {
    const float* wg = p.in[which ? 23 : 9]; const float* wu = p.in[which ? 24 : 10]; const float* wd = p.in[which ? 25 : 11];
    bf16_t* wup = (bf16_t*)(p.ws + OFF_WUP); bf16_t* wdn = (bf16_t*)(p.ws + OFF_WDN);
    for (int j = first; j < 1408 + 704; j += stride) {
        if (j < 1408) { const int q = j >> 4, kt = j & 15; const int pp = q >> 2, bj = (q >> 1) & 1, hf = q & 1;
            tr_tile(tl, bj ? wu : wg, DFF, 64 * kt, 128 * pp + 64 * hf, wup, 1024, 64 * q, 1.f); }
        else { const int jj = j - 1408; const int nb = jj / 44, kt = jj % 44; tr_tile(tl, wd, 1024, 64 * kt, 64 * nb, wdn, DFF, 64 * nb, 1.f); }
    }
}
DI void prep_phase(LAS unsigned char* lds, CParams& p) {
    LAS float* tl = (LAS float*)lds;
    const int tid = TID();
    { const float* c = p.in[4]; const float* cctx = p.in[5]; const float* wada = p.in[6]; const float* bada = p.in[7]; float* mod = (float*)(p.ws + OFF_MOD);
      LAS float* sl = tl; LAS float* rd = tl + 5 * 1024;
      for (int job = BID(); job < 256; job += gridDim.x) {
          __syncthreads();
          for (int i = tid; i < 5 * 1024; i += 512) { const int v = i >> 10, k = i & 1023; sl[i] = siluf_(v < 4 ? c[v * 1024 + k] : cctx[k]); }
          __syncthreads();
          if (tid < 504) { const int col = tid % 36, kg = tid / 36; float a0 = 0.f, a1 = 0.f, a2 = 0.f, a3 = 0.f, a4 = 0.f;
#pragma unroll 4
              for (int k = kg; k < 1024; k += 14) { const float w = wada[(size_t)k * 9216 + job * 36 + col]; a0 += sl[k] * w; a1 += sl[1024 + k] * w; a2 += sl[2048 + k] * w; a3 += sl[3072 + k] * w; a4 += sl[4096 + k] * w; }
              LAS float* o = rd + kg * 180 + col; o[0] = a0; o[36] = a1; o[72] = a2; o[108] = a3; o[144] = a4; }
          __syncthreads();
          if (tid < 180) { const int v = tid / 36, col = tid % 36; float sum = bada[job * 36 + col];
#pragma unroll
              for (int kg = 0; kg < 14; ++kg) sum += rd[kg * 180 + tid];
              mod[v * 9216 + job * 36 + col] = sum; }
      }
      __syncthreads(); }
    conv_ffn(tl, p, 0, BID(), gridDim.x);
}
DI void prep_b(LAS unsigned char* lds, CParams& p, int first, int stride) {
    LAS float* tl = (LAS float*)lds;
    const int tid = TID();
    { const float* win = p.in[13]; bf16_t* wins = (bf16_t*)(p.ws + OFF_WINS); bf16_t* winn = (bf16_t*)(p.ws + OFF_WINN);
      bf16_t* wpf = (bf16_t*)(p.ws + OFF_WPF); bf16_t* wpg = (bf16_t*)(p.ws + OFF_WPG); bf16_t* wout = (bf16_t*)(p.ws + OFF_WOUT);
      for (int j = first; j < 512 + 784 + 128 + 256 + 256; j += stride) {
          if (j < 512) { const int rb = j >> 4, kt = j & 15; tr_tile(tl, win, 5664, 64 * kt, 512 + 64 * rb, wins, 1024, 1024 + 64 * rb, rb < 8 ? 0.08838834764831845f : 1.f); }
          else if (j < 1296) { const int jj = j - 512; const int rb = jj >> 4, kt = jj & 15; const int c0 = rb < 16 ? 2560 + 64 * rb : (rb < 48 ? 3616 + 64 * (rb - 16) : 3584);
              tr_tile(tl, win, 5664, 64 * kt, c0, winn, 1024, 64 * rb, 1.f); }
          else if (j < 1424) { const int jj = j - 1296; const int rb = jj >> 3, kt = jj & 7; tr_tile(tl, p.in[19], 1024, 64 * kt, 64 * rb, wpf, 1536, 64 * rb, 1.f); }
          else if (j < 1680) { const int jj = j - 1424; const int rb = jj >> 4, kt = jj & 15; tr_tile(tl, p.in[20], 1024, 64 * kt, 64 * rb, wpf + 512, 1536, 64 * rb, 1.f); }
          else { const int jj = j - 1680; const int rb = jj >> 4, kt = jj & 15; tr_tile(tl, p.in[21], 1024, 64 * kt, 64 * rb, wout, 1024, 64 * rb, 1.f); }
      }
      LAS float* wf = tl; LAS float* ct = tl + 64 * 129; LAS float* st = ct + 128;
      for (int j = first; j < 128; j += stride) {
          const int kt = j >> 3, g = (j >> 1) & 3, lh = j & 1;
          __syncthreads();
          if (tid < 128) { float s, c; sincospif((float)tid * (1.f / 64.f), &s, &c); ct[tid] = c; st[tid] = s; }
#pragma unroll
          for (int i = 0; i < 4; ++i) { const int e = tid + 512 * i; const int r = e >> 5, c4 = e & 31; const f32x4 v = *(const f32x4*)(win + (size_t)(64 * kt + r) * 5664 + g * 128 + 4 * c4);
              LAS float* d = wf + r * 129 + 4 * c4; d[0] = v[0]; d[1] = v[1]; d[2] = v[2]; d[3] = v[3]; }
          __syncthreads();
          const int w = tid >> 6, k = tid & 63; const int l0 = 64 * lh + 8 * w;
          float ac[8], as[8];
#pragma unroll
          for (int i = 0; i < 8; ++i) { ac[i] = 0.f; as[i] = 0.f; }
          for (int c = 0; c < 128; ++c) { const float x = wf[k * 129 + c];
#pragma unroll
              for (int i = 0; i < 8; ++i) { const int idx = (c * (l0 + i)) & 127; ac[i] += x * ct[idx]; as[i] += x * st[idx]; } }
#pragma unroll
          for (int i = 0; i < 8; ++i) { const int row = g * 128 + l0 + i; const unsigned a = pk2(ac[i], -as[i]);
              wins[(size_t)row * 1024 + 64 * kt + k] = (bf16_t)(a & 0xffffu); wins[(size_t)(512 + row) * 1024 + 64 * kt + k] = (bf16_t)(a >> 16); }
      }
    }
}
DI void modreduce_phase(CParams&) {}
template <int MODE, int NR> DI void norm_rows(CParams& p, int m0, int stride, const f32x4 (&x)[NR][4], const f32x4 (&gain)[4], bf16_t* hbuf) {
    const int lane = TID() & 63;
    float ss[NR];
#pragma unroll
    for (int r = 0; r < NR; ++r) { ss[r] = 0.f;
#pragma unroll
        for (int i = 0; i < 4; ++i) ss[r] += x[r][i][0] * x[r][i][0] + x[r][i][1] * x[r][i][1] + x[r][i][2] * x[r][i][2] + x[r][i][3] * x[r][i][3]; }
#pragma unroll
    for (int o = 32; o >= 1; o >>= 1)
#pragma unroll
        for (int r = 0; r < NR; ++r) ss[r] += __shfl_xor(ss[r], o);
    if (MODE == 3) {
#pragma unroll
        for (int r = 0; r < NR; ++r) { const int m = m0 + r * stride; const float rinv = rsqrtf(ss[r] * (1.f / 1024.f) + 1e-6f); float* xo = p.out + (size_t)m * 1024;
#pragma unroll
            for (int i = 0; i < 4; ++i) *(f32x4*)(xo + 256 * i + 4 * lane) = x[r][i] * rinv * gain[i]; }
    } else {
        u32x2 hv[NR][4];
#pragma unroll
        for (int r = 0; r < NR; ++r) { const int m = m0 + r * stride; const float rinv = rsqrtf(ss[r] * (1.f / 1024.f) + 1e-6f);
            const float* md = (const float*)(p.ws + OFF_MOD) + modv(m) * 9216 + MODE * 3072;
#pragma unroll
            for (int i = 0; i < 4; ++i) { const int c = 256 * i + 4 * lane; const f32x4 sh = *(const f32x4*)(md + c), sc = *(const f32x4*)(md + 1024 + c);
                const f32x4 y = x[r][i] * rinv * gain[i] * (1.f + sc) + sh; hv[r][i][0] = pk2(y[0], y[1]); hv[r][i][1] = pk2(y[2], y[3]); } }
#pragma unroll
        for (int r = 0; r < NR; ++r) { const int m = m0 + r * stride;
#pragma unroll
            for (int i = 0; i < 4; ++i) { const int c = 256 * i + 4 * lane;
                if (MODE == 0) *(f32x4*)(p.out + (size_t)m * 1024 + c) = x[r][i];
                *(u32x2*)(hbuf + (size_t)m * 1024 + c) = hv[r][i]; } }
    }
}
template <int MODE> DI void norm_phase(CParams& p) {
    const int lane = TID() & 63; const int wg = BID() * 8 + (TID() >> 6), nw = gridDim.x * 8;
    const float* gsrc = p.in[MODE == 0 ? 8 : (MODE == 1 ? 12 : (MODE == 2 ? 22 : 26))];
    f32x4 gain[4];
#pragma unroll
    for (int i = 0; i < 4; ++i) gain[i] = *(const f32x4*)(gsrc + 256 * i + 4 * lane);
    bf16_t* hbuf = (bf16_t*)(p.ws + P_A);
    if (MODE == 0) {
        for (int j = wg; j < 2048 + 4096; j += nw) {
            if (j < 2048) { f32x4 x[2][4];
#pragma unroll
                for (int r = 0; r < 2; ++r)
#pragma unroll
                    for (int i = 0; i < 4; ++i) x[r][i] = *(const f32x4*)(p.in[0] + (size_t)(2 * j + r) * 1024 + 256 * i + 4 * lane);
                norm_rows<0, 2>(p, 2 * j, 1, x, gain, hbuf);
            } else {
                const int s = j - 2048; const float row = (float)(s >> 6), col = (float)(s & 63);
                f32x4 x[4][4];
#pragma unroll
                for (int b = 0; b < 4; ++b)
#pragma unroll
                    for (int i = 0; i < 4; ++i) x[b][i] = *(const f32x4*)(p.in[1] + ((size_t)b * 4096 + s) * 1024 + 256 * i + 4 * lane);
                f32x4 pe[4];
#pragma unroll
                for (int e = 0; e < 4; ++e) { const float om = expf(-(float)(4 * lane + e) * (9.210340371976184f / 256.f)); float sr, cr, sc, cc; sincosf(row * om, &sr, &cr); sincosf(col * om, &sc, &cc);
                    pe[0][e] = sr; pe[1][e] = cr; pe[2][e] = sc; pe[3][e] = cc; }
#pragma unroll
                for (int b = 0; b < 4; ++b)
#pragma unroll
                    for (int i = 0; i < 4; ++i) x[b][i] += pe[i];
                norm_rows<0, 4>(p, 4096 + s, 4096, x, gain, hbuf);
            }
        }
    } else {
        for (int j = wg; j < MT / 5; j += nw) { f32x4 x[5][4];
#pragma unroll
            for (int r = 0; r < 5; ++r)
#pragma unroll
                for (int i = 0; i < 4; ++i) {
                    if (MODE == 3) x[r][i] = *(const f32x4*)(p.out + (size_t)(5 * j + r) * 1024 + 256 * i + 4 * lane);
                    else { const u32x2 v = *(const u32x2*)(hbuf + (size_t)(5 * j + r) * 1024 + 256 * i + 4 * lane); x[r][i] = (f32x4){bflo(v[0]), bfhi(v[0]), bflo(v[1]), bfhi(v[1])}; } }
            norm_rows<MODE, 5>(p, 5 * j, 1, x, gain, hbuf); }
    }
}
template <int MODE, int NR> DI void norm_range(CParams& p, int row_lo, int row_hi, int wv, int nwv) {
    const int lane = TID() & 63;
    const float* gsrc = p.in[MODE == 1 ? 12 : (MODE == 2 ? 22 : 26)];
    f32x4 gain[4];
#pragma unroll
    for (int i = 0; i < 4; ++i) gain[i] = *(const f32x4*)(gsrc + 256 * i + 4 * lane);
    bf16_t* hbuf = (bf16_t*)(p.ws + P_A);
    for (int j = wv; j < (row_hi - row_lo) / NR; j += nwv) { f32x4 x[NR][4]; const int m0 = row_lo + NR * j;
#pragma unroll
        for (int r = 0; r < NR; ++r)
#pragma unroll
            for (int i = 0; i < 4; ++i) {
                if (MODE == 3) x[r][i] = *(const f32x4*)(p.out + (size_t)(m0 + r) * 1024 + 256 * i + 4 * lane);
                else { const u32x2 v = *(const u32x2*)(hbuf + (size_t)(m0 + r) * 1024 + 256 * i + 4 * lane); x[r][i] = (f32x4){bflo(v[0]), bfhi(v[0]), bflo(v[1]), bfhi(v[1])}; } }
        norm_rows<MODE, NR>(p, m0, 1, x, gain, hbuf); }
}
DI void dftgen_phase(LAS unsigned char* lds, CParams& p, int first, int nblk) {
    LAS float* tab = (LAS float*)lds; const int tid = TID();
    __syncthreads();
    for (int i = tid; i < 4096; i += 512) tab[i] = cospif((float)i * (1.f / 2048.f));
    __syncthreads();
    bf16_t* C = (bf16_t*)(p.ws + P_DFTC); bf16_t* S = (bf16_t*)(p.ws + P_DFTS);
    for (int i = first * 512 + tid; i < 2048 * 256; i += nblk * 512) { const int k = i >> 8, t0 = (i & 255) * 8; float c[8], s[8];
#pragma unroll
        for (int e = 0; e < 8; ++e) { const int m = (k * (t0 + e)) & 4095; c[e] = tab[m]; s[e] = tab[(m - 1024) & 4095]; }
        u32x4 oc, os;
#pragma unroll
        for (int e = 0; e < 4; ++e) { oc[e] = pk2(c[2 * e], c[2 * e + 1]); os[e] = pk2(s[2 * e], s[2 * e + 1]); }
        *(u32x4*)(C + (size_t)k * 2048 + t0) = oc; *(u32x4*)(S + (size_t)k * 2048 + t0) = os; }
    bf16_t* C2 = (bf16_t*)(p.ws + OFF_C256); bf16_t* S2 = (bf16_t*)(p.ws + OFF_S256);
    for (int i = first * 512 + tid; i < 256 * 32; i += nblk * 512) { const int k = i >> 5, t0 = (i & 31) * 8; float c[8], s[8];
#pragma unroll
        for (int e = 0; e < 8; ++e) { const int m = ((k * (t0 + e)) & 255) * 16; c[e] = tab[m]; s[e] = tab[(m - 1024) & 4095]; }
        u32x4 oc, os;
#pragma unroll
        for (int e = 0; e < 4; ++e) { oc[e] = pk2(c[2 * e], c[2 * e + 1]); os[e] = pk2(s[2 * e], s[2 * e + 1]); }
        *(u32x4*)(C2 + (size_t)k * 2048 + t0) = oc; *(u32x4*)(S2 + (size_t)k * 2048 + t0) = os; }
}
DI void fold_phase(LAS unsigned char* lds, CParams& p) {
    bf16_t* gT = (bf16_t*)(p.ws + P_GT); bf16_t* fm = (bf16_t*)(p.ws + P_FM); LAS float* red = (LAS float*)lds; const int tid = TID();
    for (int i = BID() * 512 + tid; i < 4096 * 256; i += gridDim.x * 512) {
        const int rb = i >> 8, j = i & 255; const int row = rb >> 2, b = rb & 3; const int t0 = 8 * j;
        bf16_t* base = gT + (size_t)row * MT + MCTX + b * 4096;
        const u32x4 own = *(const u32x4*)(base + t0), mir = *(const u32x4*)(base + 4096 - t0 - 8);
        const float m1 = (j > 0) ? bf2f(base[4096 - t0]) : 0.f; const float sg = row < 512 ? 1.f : -1.f;
        float o[8], mv[8];
#pragma unroll
        for (int e = 0; e < 4; ++e) { o[2 * e] = bflo(own[e]); o[2 * e + 1] = bfhi(own[e]); mv[2 * e] = bflo(mir[e]); mv[2 * e + 1] = bfhi(mir[e]); }
        o[0] += sg * m1;
#pragma unroll
        for (int e = 1; e < 8; ++e) o[e] += sg * mv[8 - e];
        u32x4 r; r[0] = pk2(o[0], o[1]); r[1] = pk2(o[2], o[3]); r[2] = pk2(o[4], o[5]); r[3] = pk2(o[6], o[7]);
        *(u32x4*)(base + t0) = r;
        float alt = bflo(r[0]) - bfhi(r[0]) + bflo(r[1]) - bfhi(r[1]) + bflo(r[2]) - bfhi(r[2]) + bflo(r[3]) - bfhi(r[3]);
#pragma unroll
        for (int of = 32; of >= 1; of >>= 1) alt += __shfl_xor(alt, of);
        __syncthreads();
        if ((tid & 63) == 0) red[tid >> 6] = alt;
        __syncthreads();
        if ((tid & 255) == 0 && row < 512) { const int w0 = tid >> 6; const float tot = red[w0] + red[w0 + 1] + red[w0 + 2] + red[w0 + 3] + bf2f(base[2048]);
            fm[(size_t)(MCTX + b * 4096 + 2048) * 512 + row] = (bf16_t)(pk2(tot * 0.001381067932004975f, 0.f) & 0xffffu); }
    }
}
constexpr int HTB = 128 * 64 * 2;
DI int lds_byte(int r, int c) { const int st = (r >> 4) * 2 + (c >> 5), rr = r & 15, cc = c & 31, ob = rr * 64 + cc * 2; return st * 1024 + (ob ^ (((ob >> 9) & 1) << 5)); }
DI void stage_rc(int b, int& R, int& C) { const int st = b / 1024, sb = b % 1024, swz = sb ^ (((sb >> 9) & 1) << 5); R = (st >> 1) * 16 + swz / 64; C = (st & 1) * 32 + (swz % 64) / 2; }
DI int perm32(int rho) { const int n = rho >> 4, i = rho & 15; return 8 * (i >> 2) + 4 * n + (i & 3); }
DI void tile_map(int L, int nM, int nN, int& pm, int& pn) {
    const int nwg = nM * nN; int wgid = L; { const int q = nwg / 8, r = nwg % 8, xcd = wgid % 8, off = wgid / 8; wgid = (xcd < r ? xcd * (q + 1) : r * (q + 1) + (xcd - r) * q) + off; }
    const int nig = 8 * nN, gid = wgid / nig, fm = gid * 8, gsz = (nM - fm) < 8 ? (nM - fm) : 8;
    pm = fm + ((wgid % nig) % gsz); pn = (wgid % nig) / gsz;
}
struct UD { const char* A[2]; const char* B[2]; int lda[2], ldb[2], nt[2]; int nseg, pm, pn, ty; };
enum { K_UP = 0, K_RES = 1, K_SW = 2, K_IN2 = 3, K_PL = 4, K_DFT = 5, K_PROJ = 6, K_RESD = 7 };
template <int KIND> struct KLd { static constexpr int A = 1024, B = 1024; };
template <> struct KLd<K_RESD> { static constexpr int A = DFF, B = DFF; };
template <> struct KLd<K_DFT> { static constexpr int A = 2048, B = MT; };
template <> struct KLd<K_PROJ> { static constexpr int A = 0, B = 1536; };
struct GP { const bf16_t* A; const bf16_t* B; int K; int gtoff; float scale; int u0, ustep, ubase, ulim; };
DI void gp_default(GP& g) { g.u0 = BID(); g.ustep = gridDim.x; g.ubase = 0; g.ulim = 0x7fffffff; }

template <int KIND> DI bool get_unit(CParams& p, const GP& g, int L, UD& u) {
    u.nseg = 1; u.ty = 0; u.A[1] = nullptr; u.B[1] = nullptr; u.lda[1] = 0; u.ldb[1] = 0; u.nt[1] = 0;
    if (KIND == K_UP) { if (L >= 80 * 22) return false; tile_map(L, 80, 22, u.pm, u.pn); u.A[0] = (const char*)(g.A + (size_t)u.pm * 256 * 1024); u.B[0] = (const char*)(g.B + (size_t)u.pn * 256 * 1024); u.lda[0] = u.ldb[0] = 1024; u.nt[0] = 16; return true; }
    if (KIND == K_RES || KIND == K_RESD) { if (L >= 80 * 4) return false; if (L < 256) tile_map(L, 64, 4, u.pm, u.pn); else { u.pm = 64 + ((L - 256) >> 2); u.pn = (L - 256) & 3; } u.A[0] = (const char*)(g.A + (size_t)u.pm * 256 * g.K); u.B[0] = (const char*)(g.B + (size_t)u.pn * 256 * g.K); u.lda[0] = u.ldb[0] = g.K; u.nt[0] = g.K / 64; return true; }
    if (KIND == K_SW) { if (L >= 5 * 80) return false; if (L < 320) tile_map(L, 4, 80, u.pm, u.pn); else { u.pm = 4; u.pn = L - 320; }
        u.A[0] = (u.pm < 4) ? (const char*)((const bf16_t*)(p.ws + OFF_WINS) + (size_t)u.pm * 256 * 1024) : (const char*)((const bf16_t*)(p.ws + OFF_WINN) + (size_t)12 * 256 * 1024); u.B[0] = (const char*)((const bf16_t*)(p.ws + P_A) + (size_t)u.pn * 256 * 1024); u.lda[0] = u.ldb[0] = 1024; u.nt[0] = 16; return true; }
    if (KIND == K_IN2) { if (L >= 640 + 320) return false; u.lda[0] = u.ldb[0] = 1024; u.nt[0] = 16; const bf16_t* h2 = (const bf16_t*)(p.ws + P_A);
        if (L < 640) { tile_map(L, 8, 80, u.pm, u.pn); u.ty = 0; u.A[0] = (const char*)((const bf16_t*)(p.ws + OFF_WINS) + (size_t)(4 + u.pm) * 256 * 1024); u.B[0] = (const char*)(h2 + (size_t)u.pn * 256 * 1024); }
        else { tile_map(L - 640, 80, 4, u.pm, u.pn); u.ty = 1; u.A[0] = (const char*)(h2 + (size_t)u.pm * 256 * 1024); u.B[0] = (const char*)((const bf16_t*)(p.ws + OFF_WINN) + (size_t)u.pn * 256 * 1024); }
        return true; }
    if (KIND == K_PL) { if (L >= 80 * 8) return false; tile_map(L, 80, 8, u.pm, u.pn); u.A[0] = (const char*)((const bf16_t*)(p.ws + P_A) + (size_t)u.pm * 256 * 1024); u.B[0] = (const char*)((const bf16_t*)(p.ws + OFF_WINN) + (size_t)(4 + u.pn) * 256 * 1024); u.lda[0] = u.ldb[0] = 1024; u.nt[0] = 16; return true; }
    if (KIND == K_DFT) { if (L >= 96) return false; u.nseg = 2; const bf16_t* gT = (const bf16_t*)(p.ws + P_GT);
        if (L < 64) { const int b = L >> 4, r = L & 15; u.pm = r >> 1; u.pn = r & 1; u.ty = b;
            u.A[0] = (const char*)((const bf16_t*)(p.ws + P_DFTC) + (size_t)u.pm * 256 * 2048); u.A[1] = (const char*)((const bf16_t*)(p.ws + P_DFTS) + (size_t)u.pm * 256 * 2048); u.lda[0] = u.lda[1] = 2048;
            u.B[0] = (const char*)(gT + (size_t)(u.pn * 256) * MT + MCTX + b * 4096); u.B[1] = (const char*)(gT + (size_t)(512 + u.pn * 256) * MT + MCTX + b * 4096); u.ldb[0] = u.ldb[1] = MT; u.nt[0] = u.nt[1] = 32; }
        else { const int j = L - 64; const int b = j >> 1; u.pm = 0; u.pn = j & 1; u.ty = 4 + b;
            u.A[0] = (const char*)(p.ws + OFF_C256); u.A[1] = (const char*)(p.ws + OFF_S256); u.lda[0] = u.lda[1] = 2048;
            u.B[0] = (const char*)(gT + (size_t)(u.pn * 256) * MT + b * 256); u.B[1] = (const char*)(gT + (size_t)(512 + u.pn * 256) * MT + b * 256); u.ldb[0] = u.ldb[1] = MT; u.nt[0] = u.nt[1] = 4; }
        return true; }
    if (KIND == K_PROJ) { if (L >= 80 * 4) return false; tile_map(L, 80, 4, u.pm, u.pn); u.nseg = 2;
        u.A[0] = (const char*)((const bf16_t*)(p.ws + P_FM) + (size_t)u.pm * 256 * 512); u.B[0] = (const char*)((const bf16_t*)(p.ws + OFF_WPF) + (size_t)u.pn * 256 * 1536); u.lda[0] = 512; u.ldb[0] = 1536; u.nt[0] = 8;
        u.A[1] = (const char*)((const bf16_t*)(p.ws + P_R) + (size_t)u.pm * 256 * 1024); u.B[1] = (const char*)((const bf16_t*)(p.ws + OFF_WPF) + (size_t)u.pn * 256 * 1536 + 512); u.lda[1] = 1024; u.ldb[1] = 1536; u.nt[1] = 16; return true; }
    return false;
}
DI void st16_wt(const void* base, unsigned voff, u32x4 v) { asm volatile("global_store_dwordx4 %0, %1, %2 sc1\n\ts_nop 1" :: "v"(voff), "v"(v), "s"(base) : "memory"); }
DI u32x4 pack8(const f32x4& a, const f32x4& b) { u32x4 o; o[0] = pk2(a[0], a[1]); o[1] = pk2(a[2], a[3]); o[2] = pk2(b[0], b[1]); o[3] = pk2(b[2], b[3]); return o; }
template <int KIND> DI void gemm_mid(CParams& p, f32x4 (&acc)[2][2][4][2], const UD& u, int wr, int wc, int fr, int fq) {
    if (KIND == K_DFT) {
        const bool lat = u.ty < 4; const float keep = lat ? 0.f : 1.f;
        char* st = (char*)(p.ws + P_STASH) + (size_t)(u.ty * 16 + u.pm * 2 + u.pn) * 262144; const unsigned lo = (unsigned)TID() * 16u;
#pragma unroll
        for (int ai = 0; ai < 2; ++ai)
#pragma unroll
            for (int bj = 0; bj < 2; ++bj)
#pragma unroll
                for (int m = 0; m < 4; ++m)
#pragma unroll
                    for (int n = 0; n < 2; ++n) { if (lat) *(f32x4*)(st + opq(lo) + (unsigned)((((ai * 2 + bj) * 4 + m) * 2 + n) * 8192)) = acc[ai][bj][m][n]; acc[ai][bj][m][n] *= keep; }
    }
    if (KIND == K_PROJ) {
        const char* zg = (const char*)(p.ws + P_ZG);
        const unsigned o0 = (unsigned)(((u.pm * 256 + wr * 64 + fr) * 2048 + u.pn * 256 + wc * 32 + 8 * fq) * 2);
#pragma unroll
        for (int ai = 0; ai < 2; ++ai)
#pragma unroll
            for (int mp = 0; mp < 2; ++mp) { u32x4 ga[2][2], gb[2][2];
#pragma unroll
                for (int mm = 0; mm < 2; ++mm)
#pragma unroll
                    for (int bj = 0; bj < 2; ++bj) { const unsigned o = opq(o0 + (unsigned)(((ai * 128 + (2 * mp + mm) * 16) * 2048 + bj * 128) * 2)); ga[mm][bj] = *(const u32x4*)(zg + o); gb[mm][bj] = *(const u32x4*)(zg + o + 2048); }
#pragma unroll
                for (int mm = 0; mm < 2; ++mm) { const int m = 2 * mp + mm;
#pragma unroll
                    for (int bj = 0; bj < 2; ++bj) {
#pragma unroll
                        for (int e = 0; e < 4; ++e) { const float a0 = bflo(ga[mm][bj][e]), a1 = bfhi(ga[mm][bj][e]), b0 = bflo(gb[mm][bj][e]), b1 = bfhi(gb[mm][bj][e]);
                            acc[ai][bj][m][e >> 1][(e & 1) * 2] *= (1.f + __expf(-b0)) * __builtin_amdgcn_rcpf(1.f + __expf(-a0)); acc[ai][bj][m][e >> 1][(e & 1) * 2 + 1] *= (1.f + __expf(-b1)) * __builtin_amdgcn_rcpf(1.f + __expf(-a1)); }
                        asm volatile("" : "+v"(acc[ai][bj][m][0]), "+v"(acc[ai][bj][m][1])); } }
                asm volatile("" ::: "memory"); }
    }
}
template <int KIND> DI void gemm_epi(CParams& p, const GP& g, f32x4 (&acc)[2][2][4][2], const UD& u, int wr, int wc, int fr, int fq) {
    const int r0 = u.pm * 256 + wr * 64 + fr, c0 = u.pn * 256 + wc * 32 + 8 * fq;
    if (KIND == K_UP) {
        bf16_t* act = (bf16_t*)(p.ws + P_ACT);
#pragma unroll
        for (int ai = 0; ai < 2; ++ai)
#pragma unroll
            for (int m = 0; m < 4; ++m) { f32x4 a, b;
#pragma unroll
                for (int e = 0; e < 4; ++e) { a[e] = siluf_(acc[ai][0][m][0][e]) * acc[ai][1][m][0][e]; b[e] = siluf_(acc[ai][0][m][1][e]) * acc[ai][1][m][1][e]; }
                st16_wt(act, (unsigned)(((r0 + ai * 128 + m * 16) * DFF + u.pn * 128 + wc * 32 + 8 * fq) * 2), pack8(a, b)); }
    } else if (KIND == K_RES || KIND == K_RESD) {
        const float* gt = (const float*)(p.ws + OFF_MOD) + (u.pm < 16 ? 4 : ((u.pm - 16) >> 4)) * 9216 + g.gtoff;
        bf16_t* xb = (bf16_t*)(p.ws + P_A);
        const float scl = fabsf(g.scale); const bool wb = g.scale > 0.f;
#pragma unroll
        for (int bj = 0; bj < 2; ++bj) { const int col = c0 + bj * 128; const f32x4 gv0 = *(const f32x4*)(gt + col) * scl, gv1 = *(const f32x4*)(gt + col + 4) * scl;
#pragma unroll
            for (int ai = 0; ai < 2; ++ai) { f32x4 xv[4][2];
#pragma unroll
                for (int m = 0; m < 4; ++m) { const float* xp = p.out + (size_t)(r0 + ai * 128 + m * 16) * 1024 + col; xv[m][0] = *(const f32x4*)xp; xv[m][1] = *(const f32x4*)(xp + 4); }
#pragma unroll
                for (int m = 0; m < 4; ++m) { const size_t ro = (size_t)(r0 + ai * 128 + m * 16) * 1024 + col; float* xp = p.out + ro;
                    const f32x4 x0 = xv[m][0] + gv0 * acc[ai][bj][m][0], x1 = xv[m][1] + gv1 * acc[ai][bj][m][1];
                    *(f32x4*)xp = x0; *(f32x4*)(xp + 4) = x1; if (wb) *(u32x4*)(xb + ro) = pack8(x0, x1); } } }
    } else if (KIND == K_SW && u.pm == 4) {
        if (wr == 0) { float* alrT = (float*)(p.ws + P_ALR);
#pragma unroll
            for (int m = 0; m < 2; ++m)
#pragma unroll
                for (int bj = 0; bj < 2; ++bj)
#pragma unroll
                    for (int n = 0; n < 2; ++n) *(f32x4*)(alrT + (size_t)(m * 16 + fr) * MT + c0 + bj * 128 + 4 * n) = acc[0][bj][m][n];
        }
    } else if (KIND == K_SW || (KIND == K_IN2 && u.ty == 0)) {
        bf16_t* dst = (KIND == K_SW) ? (bf16_t*)(p.ws + P_GT) : (bf16_t*)(p.ws + P_QKV);
#pragma unroll
        for (int ai = 0; ai < 2; ++ai)
#pragma unroll
            for (int m = 0; m < 4; ++m)
#pragma unroll
                for (int bj = 0; bj < 2; ++bj) st16_wt(dst, (unsigned)(((r0 + ai * 128 + m * 16) * MT + c0 + bj * 128) * 2), pack8(acc[ai][bj][m][0], acc[ai][bj][m][1]));
    } else if (KIND == K_IN2) {
        { bf16_t* zr = (bf16_t*)(p.ws + P_R);
#pragma unroll
            for (int ai = 0; ai < 2; ++ai)
#pragma unroll
                for (int m = 0; m < 4; ++m)
#pragma unroll
                    for (int bj = 0; bj < 2; ++bj) st16_wt(zr, (unsigned)(((r0 + ai * 128 + m * 16) * 1024 + c0 + bj * 128) * 2), pack8(acc[ai][bj][m][0], acc[ai][bj][m][1]));
        }
    } else if (KIND == K_PL) {
        bf16_t* zg = (bf16_t*)(p.ws + P_ZG);
#pragma unroll
        for (int ai = 0; ai < 2; ++ai)
#pragma unroll
            for (int m = 0; m < 4; ++m)
#pragma unroll
                for (int bj = 0; bj < 2; ++bj) st16_wt(zg, (unsigned)(((r0 + ai * 128 + m * 16) * 2048 + c0 + bj * 128) * 2), pack8(acc[ai][bj][m][0], acc[ai][bj][m][1]));
    } else if (KIND == K_DFT) {
        bf16_t* fm = (bf16_t*)(p.ws + P_FM); const bool lat = u.ty < 4; const int tok0 = lat ? MCTX + u.ty * 4096 : (u.ty - 4) * 256; const float sc = lat ? 0.001381067932004975f : 0.005524271728019903f;
        f32x4 ny[2][2];
#pragma unroll
        for (int bj = 0; bj < 2; ++bj)
#pragma unroll
            for (int n = 0; n < 2; ++n)
#pragma unroll
                for (int e = 0; e < 4; ++e) { float v = 0.f;
                    if (lat) { v = bf2f(((const bf16_t*)(p.ws + P_GT))[(size_t)(c0 + bj * 128 + 4 * n + e) * MT + tok0 + 2048]); v = (fr & 1) ? -v : v; }
                    ny[bj][n][e] = v; }
        if (!lat) {
#pragma unroll
            for (int ai = 0; ai < 2; ++ai)
#pragma unroll
                for (int m = 0; m < 4; ++m)
#pragma unroll
                    for (int bj = 0; bj < 2; ++bj) *(u32x4*)(fm + (size_t)(tok0 + r0 + ai * 128 + m * 16) * 512 + c0 + bj * 128) = pack8(acc[ai][bj][m][0] * sc, acc[ai][bj][m][1] * sc);
        } else {
            const char* st = (const char*)(p.ws + P_STASH) + (size_t)(u.ty * 16 + u.pm * 2 + u.pn) * 262144; const unsigned lo = (unsigned)TID() * 16u;
#pragma unroll
            for (int ai = 0; ai < 2; ++ai)
#pragma unroll
                for (int bj = 0; bj < 2; ++bj) { f32x4 pv[4][2];
#pragma unroll
                    for (int m = 0; m < 4; ++m) { const unsigned so = opq(lo) + (unsigned)((((ai * 2 + bj) * 4 + m) * 2) * 8192); pv[m][0] = *(const f32x4*)(st + so); pv[m][1] = *(const f32x4*)(st + so + 8192); }
#pragma unroll
                    for (int m = 0; m < 4; ++m) { const int k = r0 + ai * 128 + m * 16; const f32x4 p0 = pv[m][0] + ny[bj][0], p1 = pv[m][1] + ny[bj][1];
                        *(u32x4*)(fm + (size_t)(tok0 + k) * 512 + c0 + bj * 128) = pack8((p0 + acc[ai][bj][m][0]) * sc, (p1 + acc[ai][bj][m][1]) * sc);
                        if (k != 0) *(u32x4*)(fm + (size_t)(tok0 + 4096 - k) * 512 + c0 + bj * 128) = pack8((p0 - acc[ai][bj][m][0]) * sc, (p1 - acc[ai][bj][m][1]) * sc); }
                    asm volatile("" ::: "memory"); }
        }
    } else if (KIND == K_PROJ) {
        const char* zg = (const char*)(p.ws + P_ZG); char* mg = (char*)(p.ws + P_A1);
        const unsigned o0 = (unsigned)((r0 * 2048 + c0) * 2), q0 = (unsigned)((r0 * 1024 + c0) * 2);
#pragma unroll
        for (int ai = 0; ai < 2; ++ai) { u32x4 gbv[4][2];
#pragma unroll
            for (int m = 0; m < 4; ++m)
#pragma unroll
                for (int bj = 0; bj < 2; ++bj) gbv[m][bj] = *(const u32x4*)(zg + opq(o0 + (unsigned)(((ai * 128 + m * 16) * 2048 + bj * 128) * 2)) + 2048);
#pragma unroll
            for (int m = 0; m < 4; ++m)
#pragma unroll
                for (int bj = 0; bj < 2; ++bj) { const unsigned q = opq(q0 + (unsigned)(((ai * 128 + m * 16) * 1024 + bj * 128) * 2)); const u32x4 gb = gbv[m][bj]; f32x4 a, b;
#pragma unroll
                    for (int e = 0; e < 2; ++e) { a[2 * e] = acc[ai][bj][m][0][2 * e] * __builtin_amdgcn_rcpf(1.f + __expf(-bflo(gb[e]))); a[2 * e + 1] = acc[ai][bj][m][0][2 * e + 1] * __builtin_amdgcn_rcpf(1.f + __expf(-bfhi(gb[e])));
                        b[2 * e] = acc[ai][bj][m][1][2 * e] * __builtin_amdgcn_rcpf(1.f + __expf(-bflo(gb[2 + e]))); b[2 * e + 1] = acc[ai][bj][m][1][2 * e + 1] * __builtin_amdgcn_rcpf(1.f + __expf(-bfhi(gb[2 + e]))); }
                    *(u32x4*)(mg + q) = pack8(a, b); }
            asm volatile("" ::: "memory"); }
    }
}

template <int KIND> DI void gemm_phase(LAS unsigned char* lds, CParams& p, const GP g) {
    const int tid = TID(), wid = __builtin_amdgcn_readfirstlane(tid >> 6), lane = tid & 63, wr = wid >> 2, wc = wid & 3, fr = lane & 15, fq = lane >> 4;
    constexpr int LDA = KLd<KIND>::A, LDB = KLd<KIND>::B;
    int RA2[2], C2[2]; unsigned voffA[2], voffB[2];
#pragma unroll
    for (int i = 0; i < 2; ++i) { int R, C; stage_rc(tid * 16 + i * 8192, R, C); RA2[i] = R * 2; C2[i] = C * 2; voffA[i] = (unsigned)(R * 2 * LDA + C * 2); voffB[i] = (unsigned)(((R & ~31) + perm32(R & 31)) * 2 * LDB + C * 2); }
    const unsigned ldsw = (unsigned)wid * 1024u;
    const int aoff = lds_byte(wr * 64 + fr, fq * 8), boff = lds_byte(wc * 32 + fr, fq * 8);
#define G_SA(b, h) (((b) * 2 + (h)) * HTB)
#define G_SB(b, h) ((4 + (b) * 2 + (h)) * HTB)
#define G_STAGE_A(bufoff, gbase, ld) do { _Pragma("unroll") for (int _i = 0; _i < 2; ++_i) { unsigned _o; if (LDA != 0) { _o = voffA[_i]; asm volatile("" : "+v"(_o)); } else asm volatile("v_mad_u32_u24 %0, %1, %2, %3" : "=v"(_o) : "v"(RA2[_i]), "s"(ld), "v"(C2[_i])); \
        __builtin_amdgcn_global_load_lds((const unsigned*)((const char*)(gbase) + _o), (LAS unsigned*)(lds + (bufoff) + ldsw + _i * 8192), 16, 0, 0); } } while (0)
#define G_STAGE_B(bufoff, gbase) do { _Pragma("unroll") for (int _i = 0; _i < 2; ++_i) { unsigned _o = voffB[_i]; asm volatile("" : "+v"(_o)); \
        __builtin_amdgcn_global_load_lds((const unsigned*)((const char*)(gbase) + _o), (LAS unsigned*)(lds + (bufoff) + ldsw + _i * 8192), 16, 0, 0); } } while (0)
#define G_LDA(dst, b, h) do { _Pragma("unroll") for (int m = 0; m < 4; ++m) _Pragma("unroll") for (int k = 0; k < 2; ++k) dst[m][k] = *(const LAS bf16x8*)(lds + G_SA(b, h) + aoff + m * 2048 + k * 1024); } while (0)
#define G_LDB(dst, b, h) do { _Pragma("unroll") for (int n = 0; n < 2; ++n) _Pragma("unroll") for (int k = 0; k < 2; ++k) dst[n][k] = *(const LAS bf16x8*)(lds + G_SB(b, h) + boff + n * 2048 + k * 1024); } while (0)
#define G_MMA(ai, bj, At, Bt) do { __builtin_amdgcn_s_setprio(1); _Pragma("unroll") for (int m = 0; m < 4; ++m) _Pragma("unroll") for (int n = 0; n < 2; ++n) _Pragma("unroll") for (int k = 0; k < 2; ++k) \
        acc[ai][bj][m][n] = __builtin_amdgcn_mfma_f32_16x16x32_bf16(Bt[n][k], At[m][k], acc[ai][bj][m][n], 0, 0, 0); __builtin_amdgcn_s_setprio(0); } while (0)
#define G_WAIT_V(n) asm volatile("s_waitcnt vmcnt(" #n ")" ::: "memory")
#define G_WAIT_L(n) asm volatile("s_waitcnt lgkmcnt(" #n ")" ::: "memory")
#define G_BAR __builtin_amdgcn_s_barrier()
#define G_SCHED __builtin_amdgcn_sched_barrier(0)
#define G_UNIT(i, ud) ((g.u0 + (i) * g.ustep < g.ulim) && get_unit<KIND>(p, g, g.ubase + g.u0 + (i) * g.ustep, ud))
    UD cu; int ui = 0;
    if (!G_UNIT(0, cu)) return;
    f32x4 acc[2][2][4][2];
#pragma unroll
    for (int a = 0; a < 2; ++a)
#pragma unroll
        for (int b = 0; b < 2; ++b)
#pragma unroll
            for (int m = 0; m < 4; ++m)
#pragma unroll
                for (int n = 0; n < 2; ++n) acc[a][b][m][n] = (f32x4){0.f, 0.f, 0.f, 0.f};
    bf16x8 At[4][2], B0[2][2], B1[2][2];
    const char* cA = cu.A[0]; const char* cB = cu.B[0]; int clda = (LDA != 0) ? LDA : cu.lda[0], nt = cu.nt[0];
    {   const size_t hA = (size_t)clda * 256, hB = (size_t)LDB * 256;
        G_STAGE_B(G_SB(0, 0), cB); G_STAGE_A(G_SA(0, 0), cA, clda); G_STAGE_B(G_SB(0, 1), cB + hB); G_STAGE_A(G_SA(0, 1), cA + hA, clda);
        if (wr == 1) G_BAR;
        G_WAIT_V(4); G_BAR;
        G_STAGE_B(G_SB(1, 0), cB + 128); G_STAGE_A(G_SA(1, 0), cA + 128, clda); G_STAGE_B(G_SB(1, 1), cB + hB + 128);
        G_WAIT_V(6); G_BAR; }
    constexpr int NSEG = (KIND == K_DFT || KIND == K_PROJ) ? 2 : 1;
    for (;;) {
        bool has_next = true;
#pragma unroll
        for (int sg = 0; sg < NSEG; ++sg) {
            const char* nA; const char* nB; int nlda, nnt;
            if (sg + 1 < NSEG) { nA = cu.A[1]; nB = cu.B[1]; nlda = cu.lda[1]; nnt = cu.nt[1]; }
            else { UD nu; has_next = G_UNIT(ui + 1, nu);
                if (has_next) { nA = nu.A[0]; nB = nu.B[0]; nlda = nu.lda[0]; nnt = nu.nt[0]; } else { nA = cA; nB = cB; nlda = clda; nnt = nt; } }
            if (LDA != 0) nlda = LDA;
            const size_t chA = (size_t)clda * 256;
            for (int t = 0; t < nt; t += 2) {
                const bool last = (t == nt - 2);
                const char* a1 = cA + (size_t)(t + 1) * 128;
                const char* a2 = last ? nA : cA + (size_t)(t + 2) * 128; const char* b2 = last ? nB : cB + (size_t)(t + 2) * 128;
                const int lda2 = (LDA != 0) ? LDA : (last ? nlda : clda); const size_t hA2 = (size_t)lda2 * 256, hB2 = (size_t)LDB * 256;
                const char* a3 = a2 + 128; const char* b3 = b2 + 128;
                G_LDB(B0, 0, 0); G_SCHED; G_LDA(At, 0, 0); G_STAGE_A(G_SA(1, 1), a1 + chA, clda);
                G_WAIT_L(8); G_BAR; G_WAIT_L(0); G_MMA(0, 0, At, B0); G_BAR; G_SCHED;
                G_LDB(B1, 0, 1); G_STAGE_B(G_SB(0, 0), b2);
                G_BAR; G_WAIT_L(0); G_MMA(0, 1, At, B1); G_BAR;
                G_LDA(At, 0, 1); G_STAGE_A(G_SA(0, 0), a2, lda2);
                G_BAR; G_WAIT_L(0); G_MMA(1, 0, At, B0); G_BAR; G_SCHED;
                G_STAGE_B(G_SB(0, 1), b2 + hB2);
                G_WAIT_V(6); G_BAR; G_MMA(1, 1, At, B1); G_BAR;
                G_LDB(B0, 1, 0); G_SCHED; G_LDA(At, 1, 0); G_STAGE_A(G_SA(0, 1), a2 + hA2, lda2);
                G_WAIT_L(8); G_BAR; G_WAIT_L(0); G_MMA(0, 0, At, B0); G_BAR; G_SCHED;
                G_LDB(B1, 1, 1); G_STAGE_B(G_SB(1, 0), b3);
                G_BAR; G_WAIT_L(0); G_MMA(0, 1, At, B1); G_BAR;
                G_LDA(At, 1, 1); G_STAGE_A(G_SA(1, 0), a3, lda2);
                G_BAR; G_WAIT_L(0); G_MMA(1, 0, At, B0); G_BAR; G_SCHED;
                G_STAGE_B(G_SB(1, 1), b3 + hB2);
                G_WAIT_V(6); G_BAR; G_MMA(1, 1, At, B1); G_BAR;
            }
            if (sg + 1 < NSEG) gemm_mid<KIND>(p, acc, cu, wr, wc, fr, fq); else gemm_epi<KIND>(p, g, acc, cu, wr, wc, fr, fq);
            cA = nA; cB = nB; clda = nlda; nt = nnt;
        }
        if (!has_next) break;
#pragma unroll
        for (int a = 0; a < 2; ++a)
#pragma unroll
            for (int b = 0; b < 2; ++b)
#pragma unroll
                for (int m = 0; m < 4; ++m)
#pragma unroll
                    for (int n = 0; n < 2; ++n) acc[a][b][m][n] = (f32x4){0.f, 0.f, 0.f, 0.f};
        ++ui; (void)G_UNIT(ui, cu);
    }
    G_WAIT_V(0);
    if (wr == 0) G_BAR;
    G_BAR;
}

constexpr int QS = 136, KS = 40;
#define MFMA32(a, b, c) __builtin_amdgcn_mfma_f32_32x32x16_bf16((a), (b), (c), 0, 0, 0)
DI bf16x8 packS(const f32x16& x, int kk) { u32x4 o; o[0] = pk2(x[8 * kk], x[8 * kk + 1]); o[1] = pk2(x[8 * kk + 2], x[8 * kk + 3]); o[2] = pk2(x[8 * kk + 4], x[8 * kk + 5]); o[3] = pk2(x[8 * kk + 6], x[8 * kk + 7]); return __builtin_bit_cast(bf16x8, o); }
template <int MODE, int DIR> DI void gla_phase(LAS unsigned char* lds, CParams& p) {
    LAS float* a_s = (LAS float*)lds; LAS float* eb_s = (LAS float*)(lds + 8192); LAS float* red = (LAS float*)(lds + 10240); LAS float* dsum = (LAS float*)(lds + 12288);
    LAS bf16_t* qts = (LAS bf16_t*)(lds + 14336); LAS bf16_t* kts = (LAS bf16_t*)(lds + 49152); LAS bf16_t* khs = (LAS bf16_t*)(lds + 83968);
    const int tid = TID(), w = tid >> 6, lane = tid & 63, r32 = lane & 31, hh = lane >> 5, cg = tid >> 7, c = tid & 127;
    const bf16_t* qkvT = (const bf16_t*)(p.ws + P_QKV); const float* alr = (const float*)(p.ws + P_ALR); bf16_t* Ub = (bf16_t*)(p.ws + P_U); float* Dbuf = (float*)(p.ws + OFF_DBUF);
    bf16_t* of = (bf16_t*)(p.ws + P_A1); bf16_t* zr = (bf16_t*)(p.ws + P_R);
    const int nitems = (MODE == 1) ? 256 : 320; constexpr int dir = DIR;
    for (int it = BID(); it < nitems; it += gridDim.x) {
        int h, b, isctx, m0, slot;
        if (MODE == 1) { const int sg = it & 15; h = (it >> 4) & 3; b = it >> 6; isctx = 0; slot = ((b * 4 + h) * 2 + dir) * 16 + sg; m0 = MCTX + 4096 * b + 256 * (dir ? 15 - sg : sg); }
        else {
            if (it < 64) { isctx = 1; b = it >> 2; h = it & 3; m0 = 256 * b; slot = -1; }
            else { const int j = it - 64; const int sg = j & 15; h = (j >> 4) & 3; b = j >> 6; isctx = 0; slot = ((b * 4 + h) * 2 + dir) * 16 + sg; m0 = MCTX + 4096 * b + 256 * (dir ? 15 - sg : sg); } }
        const float* walpha = p.in[dir ? 16 : 14]; const float* balpha = p.in[dir ? 17 : 15];
        f32x16 S[4];
        if (MODE != 1 && slot >= 0) {
#pragma unroll
            for (int d = 0; d < 4; ++d)
#pragma unroll
                for (int q = 0; q < 16; ++q) { const char* up = (const char*)(Ub + ((size_t)slot * 8 + __builtin_amdgcn_readfirstlane(w)) * 4096 + (16 * d + q) * 64); S[d][q] = bf2f(*(const bf16_t*)(up + opq((unsigned)lane * 2u))); }
        } else {
#pragma unroll
            for (int d = 0; d < 4; ++d)
#pragma unroll
                for (int q = 0; q < 16; ++q) S[d][q] = 0.f;
        }
        float dacc = 0.f;
#pragma unroll 1
        for (int g = 0; g < 2; ++g) {
            const int gbase = m0 + 128 * (dir ? 1 - g : g);
            { const int r = tid >> 5, t4 = tid & 31; *(LAS f32x4*)(a_s + r * 128 + 4 * t4) = *(const f32x4*)(alr + (size_t)(dir * 16 + r) * MT + gbase + 4 * t4); }
            __syncthreads();
            {
                float wv[16];
#pragma unroll
                for (int r = 0; r < 16; ++r) wv[r] = walpha[r * 512 + h * 128 + c];
                const float bias = balpha[h * 128 + c];
                const int ci = dir ? 7 - (4 * g + cg) : 4 * g + cg; const int tb = m0 + 32 * ci; const int loc = tb - gbase;
                u32x4 kq[4], qq[4];
                const char* kbase = (const char*)(qkvT + (size_t)(512 + h * 128) * MT + tb); const char* qbase = (const char*)(qkvT + (size_t)(h * 128) * MT + tb);
                const unsigned coff = opq((unsigned)c * (unsigned)(MT * 2));
#pragma unroll
                for (int i = 0; i < 4; ++i) { kq[i] = *(const u32x4*)(kbase + coff + 16 * i); if (MODE != 1) qq[i] = *(const u32x4*)(qbase + coff + 16 * i); }
                float run = 0.f;
#pragma unroll
                for (int i4s = 0; i4s < 4; ++i4s) { const int i4 = DIR ? 3 - i4s : i4s; float khv[8];
#pragma unroll
                    for (int hs = 0; hs < 2; ++hs) { const int hf = DIR ? 1 - hs : hs; f32x4 xv = {bias, bias, bias, bias};
#pragma unroll
                        for (int r = 0; r < 16; ++r) xv += *(LAS const f32x4*)(a_s + r * 128 + loc + 8 * i4 + 4 * hf) * wv[r];
#pragma unroll
                        for (int es = 0; es < 4; ++es) { const int e4 = DIR ? 3 - es : es; const int e = 4 * hf + e4; const int i = 8 * i4 + e; const float x = xv[e4];
                            const float ls = fminf(x, 0.f) - __logf(1.f + __expf(-fabsf(x)));
                            run += ls * (1.f / 16.f);
                            const float kv = (e & 1) ? bfhi(kq[i4][e >> 1]) : bflo(kq[i4][e >> 1]);
                            const float kd = kv * __expf(-run); khv[e] = kd;
                            if (MODE != 1) { const float qv = (e & 1) ? bfhi(qq[i4][e >> 1]) : bflo(qq[i4][e >> 1]);
                                const unsigned pq = pk2(qv * __expf(run), kd);
                                qts[(cg * 32 + i) * QS + c] = (bf16_t)(pq & 0xffffu); kts[(cg * 32 + i) * QS + c] = (bf16_t)(pq >> 16); } }
                        asm volatile("" ::: "memory"); }
                    u32x4 kh; kh[0] = pk2(khv[0], khv[1]); kh[1] = pk2(khv[2], khv[3]); kh[2] = pk2(khv[4], khv[5]); kh[3] = pk2(khv[6], khv[7]);
                    *(LAS u32x4*)(khs + (cg * 128 + c) * KS + 8 * i4) = kh; }
                const float tot = run; dacc += tot;
                eb_s[cg * 128 + c] = __expf(tot);
            }
            bf16x8 vnx[2];
            {
                const int ci0 = dir ? 7 - 4 * g : 4 * g; const char* vb0 = (const char*)(qkvT + (size_t)(1024 + h * 256) * MT + m0 + 32 * ci0); const unsigned vo = opq((unsigned)(32 * w + r32) * (unsigned)(MT * 2) + 8u * hh);
#pragma unroll
                for (int kk = 0; kk < 2; ++kk) { const s16x4 lo = *(const s16x4*)(vb0 + vo + 32 * kk), hi = *(const s16x4*)(vb0 + vo + 32 * kk + 16); vnx[kk] = __builtin_shufflevector(lo, hi, 0, 1, 2, 3, 4, 5, 6, 7); } }
            __syncthreads();
#pragma unroll 1
            for (int s = 0; s < 4; ++s) {
                const int ci = dir ? 7 - (4 * g + s) : 4 * g + s; const int tb = m0 + 32 * ci;
                const char* vbase = (const char*)(qkvT + (size_t)(1024 + h * 256) * MT + tb);
                const unsigned voff = opq((unsigned)(32 * w + r32) * (unsigned)(MT * 2) + 8u * hh);
                const char* obase = (const char*)(of + (size_t)tb * 1024 + h * 256); const char* rbase = (const char*)(zr + (size_t)tb * 1024 + h * 256);
                const unsigned ooff = opq((unsigned)((r32 * 1024 + 32 * w + 4 * hh) * 2));
                bf16x8 vf[2]; vf[0] = vnx[0]; vf[1] = vnx[1];
                if (s < 3) { const int cin = dir ? ci - 1 : ci + 1; const char* vbn = vbase + (cin - ci) * 64;
#pragma unroll
                    for (int kk = 0; kk < 2; ++kk) { const s16x4 lo = *(const s16x4*)(vbn + voff + 32 * kk), hi = *(const s16x4*)(vbn + voff + 32 * kk + 16); vnx[kk] = __builtin_shufflevector(lo, hi, 0, 1, 2, 3, 4, 5, 6, 7); } }
                f32x16 O;
                if (MODE != 1) {
                    LAS const bf16_t* kt_ = kts + (s * 32 + r32) * QS; LAS const bf16_t* qt_ = qts + (s * 32 + r32) * QS;
                    f32x16 PT;
#pragma unroll
                    for (int q = 0; q < 16; ++q) { PT[q] = 0.f; O[q] = 0.f; }
#pragma unroll
                    for (int ks = 0; ks < 8; ++ks) { const bf16x8 A = *(LAS const bf16x8*)(kt_ + 16 * ks + 8 * hh), B = *(LAS const bf16x8*)(qt_ + 16 * ks + 8 * hh); PT = MFMA32(A, B, PT); }
                    { const int rl = (int)opq((unsigned)r32) - 4 * hh;
#pragma unroll
                    for (int q = 0; q < 16; ++q) { const int j = 8 * (q >> 2) + (q & 3); const bool keep = dir ? (j >= rl) : (j <= rl); PT[q] = keep ? PT[q] : 0.f; } }
#pragma unroll
                    for (int d = 0; d < 4; ++d)
#pragma unroll
                        for (int kk = 0; kk < 2; ++kk) { const s16x4 lo = *(LAS const s16x4*)(qt_ + 32 * d + 16 * kk + 4 * hh), hi = *(LAS const s16x4*)(qt_ + 32 * d + 16 * kk + 8 + 4 * hh);
                            O = MFMA32(packS(S[d], kk), __builtin_shufflevector(lo, hi, 0, 1, 2, 3, 4, 5, 6, 7), O); }
#pragma unroll
                    for (int kk = 0; kk < 2; ++kk) O = MFMA32(vf[kk], packS(PT, kk), O);
                }
#pragma unroll
                for (int d = 0; d < 4; ++d) {
                    LAS const bf16_t* kh = khs + (s * 128 + 32 * d + r32) * KS;
#pragma unroll
                    for (int kk = 0; kk < 2; ++kk) { const s16x4 lo = *(LAS const s16x4*)(kh + 16 * kk + 4 * hh), hi = *(LAS const s16x4*)(kh + 16 * kk + 8 + 4 * hh);
                        S[d] = MFMA32(__builtin_shufflevector(lo, hi, 0, 1, 2, 3, 4, 5, 6, 7), vf[kk], S[d]); }
#pragma unroll
                    for (int g4 = 0; g4 < 4; ++g4) { const f32x4 ev = *(LAS const f32x4*)(eb_s + s * 128 + 32 * d + 8 * g4 + 4 * hh);
#pragma unroll
                        for (int r = 0; r < 4; ++r) S[d][4 * g4 + r] *= ev[r]; }
                }
                if (MODE == 2) {
#pragma unroll
                    for (int g4 = 0; g4 < 4; ++g4) { u32x2 o2; o2[0] = pk2(O[4 * g4], O[4 * g4 + 1]); o2[1] = pk2(O[4 * g4 + 2], O[4 * g4 + 3]);
                        *(u32x2*)(const_cast<char*>(obase) + ooff + 16 * g4) = o2; }
                }
                if (MODE == 3) {
                    const int par = s & 1; float ov[16]; float ss = 0.f;
#pragma unroll
                    for (int g4 = 0; g4 < 4; ++g4) { const u32x2 f = *(const u32x2*)(obase + ooff + 16 * g4);
                        ov[4 * g4] = O[4 * g4] + bflo(f[0]); ov[4 * g4 + 1] = O[4 * g4 + 1] + bfhi(f[0]); ov[4 * g4 + 2] = O[4 * g4 + 2] + bflo(f[1]); ov[4 * g4 + 3] = O[4 * g4 + 3] + bfhi(f[1]); }
#pragma unroll
                    for (int q = 0; q < 16; ++q) ss += ov[q] * ov[q];
                    ss += __shfl_xor(ss, 32);
                    if (hh == 0) red[(par * 8 + w) * 32 + r32] = ss;
                    __syncthreads();
                    float tot = 0.f;
#pragma unroll
                    for (int w2 = 0; w2 < 8; ++w2) tot += red[(par * 8 + w2) * 32 + r32];
                    const float rinv = rsqrtf(tot * (1.f / 256.f) + 1e-6f);
                    u32x2 rrv[4];
#pragma unroll
                    for (int g4 = 0; g4 < 4; ++g4) rrv[g4] = *(const u32x2*)(rbase + ooff + 16 * g4);
#pragma unroll
                    for (int g4 = 0; g4 < 4; ++g4) { const int dv0 = h * 256 + 32 * w + 8 * g4 + 4 * hh; const f32x4 gn = *(const f32x4*)(p.in[18] + dv0);
                        char* rp = const_cast<char*>(rbase) + ooff + 16 * g4; const u32x2 rr = rrv[g4];
                        u32x2 o2; o2[0] = pk2(ov[4 * g4] * rinv * gn[0] * siluf_(bflo(rr[0])), ov[4 * g4 + 1] * rinv * gn[1] * siluf_(bfhi(rr[0])));
                        o2[1] = pk2(ov[4 * g4 + 2] * rinv * gn[2] * siluf_(bflo(rr[1])), ov[4 * g4 + 3] * rinv * gn[3] * siluf_(bfhi(rr[1])));
                        *(u32x2*)rp = o2; }
                }
            }
        }
        if (MODE == 1) {
#pragma unroll
            for (int d = 0; d < 4; ++d)
#pragma unroll
                for (int q = 0; q < 16; q += 2) { const unsigned u2 = pk2(S[d][q], S[d][q + 1]); char* up = (char*)(Ub + ((size_t)slot * 8 + __builtin_amdgcn_readfirstlane(w)) * 4096 + (16 * d + q) * 64); const unsigned lo = opq((unsigned)lane * 2u);
                    *(bf16_t*)(up + lo) = (bf16_t)(u2 & 0xffffu); *(bf16_t*)(up + 128 + lo) = (bf16_t)(u2 >> 16); }
            dsum[cg * 128 + c] = dacc;
            __syncthreads();
            if (tid < 128) Dbuf[slot * 128 + tid] = __expf(dsum[tid] + dsum[128 + tid] + dsum[256 + tid] + dsum[384 + tid]);
        } else if (isctx) {
            float* so = p.out + (size_t)MT * 1024 + (size_t)dir * 2097152 + (size_t)(b * 4 + h) * 128 * 256;
#pragma unroll
            for (int d = 0; d < 4; ++d)
#pragma unroll
                for (int q = 0; q < 16; ++q) { char* sp = (char*)(so + (size_t)(32 * d + 8 * (q >> 2) + (q & 3)) * 256); *(float*)(sp + opq((unsigned)((4 * hh * 256 + 32 * w + r32) * 4))) = S[d][q]; }
        }
        __syncthreads();
    }
}
DI void gla_pass2(CParams& p) {
    bf16_t* Ub = (bf16_t*)(p.ws + P_U); const float* Dbuf = (const float*)(p.ws + OFF_DBUF);
    for (int gid = BID() * 512 + TID(); gid < 131072; gid += gridDim.x * 512) {
        const int bhd = gid >> 12, rem = gid & 4095, w = rem >> 9, reg = (rem >> 3) & 63, l8 = rem & 7;
        const int d = reg >> 4, q = reg & 15, hh = l8 >> 2; const int dk = 32 * d + 8 * (q >> 2) + 4 * hh + (q & 3), dv0 = 32 * w + ((8 * l8) & 31);
        const int b = bhd >> 3, h = (bhd >> 1) & 3, dir = bhd & 1;
        const float* s0 = p.in[dir ? 3 : 2] + ((size_t)(b * 4 + h) * 128 + dk) * 256 + dv0;
        float cy[8]; { const f32x4 x0 = *(const f32x4*)s0, x1 = *(const f32x4*)(s0 + 4); cy[0] = x0[0]; cy[1] = x0[1]; cy[2] = x0[2]; cy[3] = x0[3]; cy[4] = x1[0]; cy[5] = x1[1]; cy[6] = x1[2]; cy[7] = x1[3]; }
        for (int sg = 0; sg < 16; ++sg) { bf16_t* sp = Ub + ((size_t)(bhd * 16 + sg) * 8 + w) * 4096 + reg * 64 + 8 * l8; const u32x4 u = *(const u32x4*)sp; const float D = Dbuf[(bhd * 16 + sg) * 128 + dk];
            u32x4 o; o[0] = pk2(cy[0], cy[1]); o[1] = pk2(cy[2], cy[3]); o[2] = pk2(cy[4], cy[5]); o[3] = pk2(cy[6], cy[7]); *(u32x4*)sp = o;
#pragma unroll
            for (int e = 0; e < 4; ++e) { cy[2 * e] = D * cy[2 * e] + bflo(u[e]); cy[2 * e + 1] = D * cy[2 * e + 1] + bfhi(u[e]); } }
    }
}


#define XB_TMO      128
#define XB_XCNT(j)  (256  + 64 * (j))
#define XB_XSUB(j)  (1280 + 64 * (j))
#define XB_XGEN(j)  (2304 + 64 * (j))
#define XB_TOP      3328
#define XB_TOPGEN   3392
#define XCD_BAR_WORDS 3456
#define XB_SPIN_CAP (1u << 20)
DI unsigned xb_ld(unsigned* p)              { return __hip_atomic_load(p, __ATOMIC_RELAXED, __HIP_MEMORY_SCOPE_AGENT); }
DI unsigned xb_add(unsigned* p, unsigned v) { return __hip_atomic_fetch_add(p, v, __ATOMIC_RELAXED, __HIP_MEMORY_SCOPE_AGENT); }
DI unsigned xb_xcc_id() { return (unsigned)__builtin_amdgcn_s_getreg((3 << 11) | 20) & 0xFu; }
#define XB_SPIN(cond, bar) do { unsigned _sp = 0; while (cond) { __builtin_amdgcn_s_sleep(1); \
    if ((++_sp & 255u) == 0u) { if (xb_ld(&(bar)[XB_TMO])) break; if (_sp > XB_SPIN_CAP) { atomicAdd(&(bar)[XB_TMO], 1u); break; } } } } while (0)
struct XcdBarrier { unsigned* bar; unsigned x; volatile LAS unsigned* st; };
DI XcdBarrier xcd_barrier_post(unsigned* bar, volatile LAS unsigned* st) {
    XcdBarrier b; b.bar = bar; b.x = xb_xcc_id(); b.st = st;
    if (threadIdx.x == 0) (void)xb_add(&bar[XB_XCNT(b.x)], 1u);
    return b;
}
DI void xcd_barrier_complete(unsigned* bar, unsigned x, unsigned& nloc, unsigned& nx) {
    const unsigned G = gridDim.x * gridDim.y * gridDim.z;
    unsigned sum, cnt, mine, sp = 0u;
    for (;;) {
        sum = 0u; cnt = 0u; mine = 0u;
#pragma unroll
        for (unsigned j = 0; j < 16; ++j) { const unsigned c = xb_ld(&bar[XB_XCNT(j)]); sum += c; cnt += (c > 0u) ? 1u : 0u; mine = (j == x) ? c : mine; }
        if (sum == G) break;
        __builtin_amdgcn_s_sleep(1);
        if ((++sp & 255u) == 0u) { if (xb_ld(&bar[XB_TMO])) break; if (sp > XB_SPIN_CAP) { atomicAdd(&bar[XB_TMO], 1u); break; } }
    }
    nloc = mine > 0u ? mine : 1u; nx = cnt > 0u ? cnt : 1u;
}
DI void xcd_barrier(const XcdBarrier& b) {
    asm volatile("s_waitcnt vmcnt(0)" ::: "memory");
    __syncthreads();
    if (threadIdx.x == 0) {
        unsigned* bar = b.bar;
        __builtin_amdgcn_s_waitcnt(0);
        unsigned nloc = b.st[0], nx = b.st[1];
        if (nloc == 0u) { xcd_barrier_complete(bar, b.x, nloc, nx); b.st[0] = nloc; b.st[1] = nx; }
        const unsigned old = xb_add(&bar[XB_XSUB(b.x)], 1u);
        const unsigned gen = old / nloc;
        if (old + 1u == (gen + 1u) * nloc) {
            __builtin_amdgcn_fence(__ATOMIC_RELEASE, "agent");
            asm volatile("s_waitcnt vmcnt(0)" ::: "memory");
            const unsigned og = xb_add(&bar[XB_TOP], 1u);
            const unsigned tg = og / nx;
            if (og + 1u == (tg + 1u) * nx) xb_add(&bar[XB_TOPGEN], 1u);
            else XB_SPIN(xb_ld(&bar[XB_TOPGEN]) == tg, bar);
            __builtin_amdgcn_fence(__ATOMIC_ACQUIRE, "agent");
            xb_add(&bar[XB_XGEN(b.x)], 1u);
            asm volatile("s_waitcnt vmcnt(0)" ::: "memory");
        } else {
            XB_SPIN(xb_ld(&bar[XB_XGEN(b.x)]) == gen, bar);
            __builtin_amdgcn_fence(__ATOMIC_ACQUIRE, "agent");
            asm volatile("s_waitcnt vmcnt(0)" ::: "memory");
        }
    }
    __syncthreads();
}

__global__ void __launch_bounds__(512, 2) fwd_megakernel(Params p_arg) {
    extern __shared__ __attribute__((aligned(16))) unsigned char shm[];
    LAS unsigned char* lds = (LAS unsigned char*)shm;
    cg::grid_group grid = cg::this_grid();
    volatile LAS unsigned* xst = (volatile LAS unsigned*)(lds + 131072);
    if (threadIdx.x == 0) { xst[0] = 0u; xst[1] = 0u; }
    __syncthreads();
    const XcdBarrier xb = xcd_barrier_post((unsigned*)(p_arg.ws + OFF_BAR), xst);
    const int nseq = p_arg.nseq;
    for (int si = 0; si < nseq; ++si) {
        unsigned long long kp = (unsigned long long)__builtin_amdgcn_kernarg_segment_ptr(); asm volatile("" : "+s"(kp));
        CParams& p = *(CParams*)kp;
        const int ph = p.seq[si];
        const bf16_t* hA = (const bf16_t*)(p.ws + P_A);
        switch (ph) {
        case 0: if (PH_ON(0)) prep_phase(lds, p); break;
        case 1: if (PH_ON(1)) modreduce_phase(p); break;
        case 2: if (PH_ON(2)) norm_phase<0>(p); break;
        case 3: case 18: if (PH_ON(3)) { GP g{hA, (const bf16_t*)(p.ws + OFF_WUP), 1024, 0, 0.f, 0, 0, 0, 0}; gp_default(g); gemm_phase<K_UP>(lds, p, g); } break;
        case 4: case 19: if (PH_ON(4)) { GP g{(const bf16_t*)(p.ws + P_ACT), (const bf16_t*)(p.ws + OFF_WDN), DFF, ph == 4 ? 2048 : 8192, ph == 4 ? 0.5f : -0.5f, 0, 0, 0, 0}; gp_default(g); if (ph == 19) g.ulim = 256; gemm_phase<K_RESD>(lds, p, g);
                  if (ph == 4) { if (gridDim.x > 64) { if (BID() >= 64) { prep_b(lds, p, BID() - 64, gridDim.x - 64); dftgen_phase(lds, p, BID() - 64, gridDim.x - 64); } } else { prep_b(lds, p, BID(), gridDim.x); dftgen_phase(lds, p, BID(), gridDim.x); } } } break;
        case 5: if (PH_ON(5)) norm_phase<1>(p); break;
        case 6: if (PH_ON(6)) { { GP g{nullptr, nullptr, 1024, 0, 0.f, 0, 0, 0, 0}; gp_default(g); gemm_phase<K_SW>(lds, p, g); }
                  if (gridDim.x == 256) { GP g{nullptr, nullptr, 1024, 0, 0.f, 0, 0, 0, 0}; const int b = BID(); g.ubase = 0; g.u0 = b >= 144 ? b - 144 : 0; g.ustep = 112; g.ulim = b >= 144 ? 112 : 0; gemm_phase<K_IN2>(lds, p, g); } } break;
        case 7: if (PH_ON(7)) {
                  { GP g{nullptr, nullptr, 0, 0, 0.f, 0, 0, 0, 0}; gp_default(g); const int b = BID();
                    if (gridDim.x == 256) { g.ubase = 0; g.ustep = 1; if (b < 64) { g.u0 = b; g.ulim = b + 1; } else if (b >= 96 && b < 128) { g.u0 = b - 32; g.ulim = b - 31; } else { g.u0 = 0; g.ulim = 0; } }
                    gemm_phase<K_DFT>(lds, p, g); }
                  { GP g{nullptr, nullptr, 1024, 0, 0.f, 0, 0, 0, 0}; const int nb = gridDim.x, b = BID();
                    if (nb == 256) { if (b < 64) { g.ubase = 112; g.u0 = b; g.ustep = 64; g.ulim = 64; } else { g.ubase = 176; g.u0 = b - 64; g.ustep = 192; g.ulim = 784; } }
                    else gp_default(g);
                    gemm_phase<K_IN2>(lds, p, g); } } break;
        case 9: if (PH_ON(9)) { gla_phase<1, 0>(lds, p); gla_phase<1, 1>(lds, p); } break;
        case 10: if (PH_ON(10)) gla_pass2(p); break;
        case 11: case 12: if (PH_ON(11)) { if (ph == 11) gla_phase<2, 0>(lds, p); else gla_phase<3, 1>(lds, p);
                  GP g{nullptr, nullptr, 1024, 0, 0.f, 0, 0, 0, 0}; const int nb = gridDim.x, b = BID();
                  if (nb > 64) { g.u0 = b >= 64 ? b - 64 : 0; g.ustep = nb - 64; g.ulim = b >= 64 ? 320 : 0; } else { g.u0 = b; g.ustep = nb; g.ulim = 320; }
                  g.ubase = (ph == 11) ? 0 : 320; gemm_phase<K_PL>(lds, p, g); } break;
        case 13: if (PH_ON(13)) norm_phase<1>(p); break;
        case 15: if (PH_ON(15)) { GP g{nullptr, nullptr, 0, 0, 0.f, 0, 0, 0, 0}; gp_default(g); gemm_phase<K_PROJ>(lds, p, g);
                  if (gridDim.x > 64) { if (BID() >= 64) conv_ffn((LAS float*)lds, p, 1, BID() - 64, gridDim.x - 64); } else conv_ffn((LAS float*)lds, p, 1, BID(), gridDim.x); } break;
        case 16: if (PH_ON(16)) { GP g{(const bf16_t*)(p.ws + P_A1), (const bf16_t*)(p.ws + OFF_WOUT), 1024, 5120, 1.f, 0, 0, 0, 0}; gp_default(g); g.ulim = 256; gemm_phase<K_RES>(lds, p, g); } break;
        case 22: case 24: if (PH_ON(22)) {
                  const int nb = gridDim.x, b = BID(); const bool solo = nb <= 64;
                  if (b < 64 || solo) {
                      if (ph == 22) { GP g{(const bf16_t*)(p.ws + P_A1), (const bf16_t*)(p.ws + OFF_WOUT), 1024, 5120, 1.f, 0, 0, 0, 0}; g.ubase = 256; g.u0 = b; g.ustep = solo ? nb : 64; g.ulim = 64; gemm_phase<K_RES>(lds, p, g); }
                      else { GP g{(const bf16_t*)(p.ws + P_ACT), (const bf16_t*)(p.ws + OFF_WDN), DFF, 8192, -0.5f, 0, 0, 0, 0}; g.ubase = 256; g.u0 = b; g.ustep = solo ? nb : 64; g.ulim = 64; gemm_phase<K_RESD>(lds, p, g); } }
                  if (b >= 64 || solo) { const int wv = (solo ? b : b - 64) * 8 + (TID() >> 6), nwv = (solo ? nb : nb - 64) * 8;
                      if (ph == 22) norm_range<2, 4>(p, 0, 16384, wv, nwv); else norm_range<3, 4>(p, 0, 16384, wv, nwv); } } break;
        case 23: if (PH_ON(23)) norm_range<2, 4>(p, 16384, MT, BID() * 8 + (TID() >> 6), gridDim.x * 8); break;
        case 25: if (PH_ON(25)) norm_range<3, 4>(p, 16384, MT, BID() * 8 + (TID() >> 6), gridDim.x * 8); break;
        case 21: if (PH_ON(21)) fold_phase(lds, p); break;
        default: break;
        }
        if (si + 1 < nseq) { if (nseq < 0) grid.sync(); else xcd_barrier(xb); }
    }
}

extern "C" void kernel_launch(void* const* d_in, const int* in_sizes, int n_in, void* d_out, int out_size, void* d_ws, size_t ws_size, hipStream_t stream) {
    static int grid_blocks = 0;
    if (grid_blocks == 0) {
        if (n_in != 27 || ws_size < WS_NEED) { fprintf(stderr, "kernel_launch: unexpected n_in %d or ws_size %zu (need %zu)\n", n_in, ws_size, (size_t)WS_NEED); grid_blocks = -1; return; }
        int dev = 0, cus = 0, per_cu = 0;
        hipGetDevice(&dev); hipDeviceGetAttribute(&cus, hipDeviceAttributeMultiprocessorCount, dev);
        if (hipFuncSetAttribute((const void*)fwd_megakernel, hipFuncAttributeMaxDynamicSharedMemorySize, LDS_BYTES) != hipSuccess) { fprintf(stderr, "kernel_launch: hipFuncSetAttribute failed\n"); grid_blocks = -1; return; }
        if (hipOccupancyMaxActiveBlocksPerMultiprocessor(&per_cu, (const void*)fwd_megakernel, 512, LDS_BYTES) != hipSuccess || per_cu < 1) { fprintf(stderr, "kernel_launch: occupancy query failed (%d)\n", per_cu); grid_blocks = -1; return; }
        grid_blocks = cus;
        if (grid_blocks > cus * per_cu) grid_blocks = cus * per_cu;
    }
    if (grid_blocks < 0) return;
    Params p{};
    for (int i = 0; i < 27; ++i) p.in[i] = (const float*)d_in[i];
    p.out = (float*)d_out; p.ws = (unsigned char*)d_ws;
#ifndef PROBE_DUP
#define PROBE_DUP
#endif
#ifndef PROBE_AMP
#define PROBE_AMP 0u
#endif
    p.amp = PROBE_AMP;
    const int dup[] = {-1, PROBE_DUP};
    int n = 0;
    const int order[NPHASE - 1] = {0, 2, 3, 4, 5, 6, 21, 7, 9, 10, 11, 12, 15, 16, 22, 23, 18, 19, 24, 25};
    for (int oi = 0; oi < NPHASE - 1; ++oi) { const int ph = order[oi]; p.seq[n++] = ph; for (unsigned k = 1; k < sizeof(dup) / sizeof(int); ++k) if (dup[k] == ph) p.seq[n++] = ph; }
    if (hipMemsetAsync((unsigned char*)d_ws + OFF_BAR, 0, XCD_BAR_WORDS * 4, stream) != hipSuccess) { fprintf(stderr, "kernel_launch: memset of barrier words failed\n"); return; }
#if MULTI_LAUNCH
    for (int i = 0; i < n; ++i) { Params q = p; q.nseq = 1; q.seq[0] = p.seq[i]; for (int k = 1; k < 46; ++k) q.seq[k] = 0; hipLaunchKernelGGL(fwd_megakernel, dim3(grid_blocks), dim3(512), LDS_BYTES, stream, q); }
#else
    p.nseq = n;
    void* args[] = {&p};
    hipError_t e = hipLaunchCooperativeKernel((const void*)fwd_megakernel, dim3(grid_blocks), dim3(512), args, LDS_BYTES, stream);
    if (e != hipSuccess) fprintf(stderr, "kernel_launch: cooperative launch failed: %s (grid %d)\n", hipGetErrorString(e), grid_blocks);
#endif
}
```
